# Optimizing an MI355X kernel written in HIP

```python
import math
import jax
import jax.numpy as jnp
from jax import lax
import numpy as np

D_MODEL = 1024
BATCH = 4
SEQ = 4096
DEPTH = 2

HEAD_DIM = 64
A_HEADS = 6
A_WIDTH = A_HEADS * HEAD_DIM
B_Q_HEADS = 6
B_KV_HEADS = 2
B_WIDTH = B_Q_HEADS * HEAD_DIM
B_KV_WIDTH = B_KV_HEADS * HEAD_DIM
C_HEADS = 4
C_WIDTH = C_HEADS * HEAD_DIM
D_MIX = A_WIDTH + B_WIDTH + C_WIDTH
IN_SPLITS = (3 * A_WIDTH, A_WIDTH, 2 * A_HEADS, 2 * A_HEADS,
             B_WIDTH, B_KV_WIDTH, B_KV_WIDTH,
             2 * C_WIDTH, C_WIDTH, C_WIDTH, C_WIDTH)
D_IN = sum(IN_SPLITS)
CONV_K = 5
GDN_CHUNK = 64
HGRN_CHUNK = 64
Q_BLOCK = 128
GRID_W = 64
ROPE_AXIS_DIM = HEAD_DIM // 2
ROPE_THETA = 10000.0
MEM_TOKENS = 256
X_HEADS = 4
X_HEAD_DIM = D_MODEL // X_HEADS
D_FF = 2816
N_EXPERTS = 8
TOP_K = 2
D_FF_EXPERT = 3584
MOE_BLOCK = 128
N_DENSE = (DEPTH + 1) // 2
N_MOE = DEPTH // 2
DN_ALPHA = (2 * DEPTH) ** 0.25
DN_BETA = (8 * DEPTH) ** -0.25
LN_EPS = 1e-5
RMS_EPS = 1e-6

kernel_name = 'hybrid_parallel_heads_deepnorm_encoder'


def layer_norm(x, g, b):
    xf = x.astype(jnp.float32)
    xc = xf - jnp.mean(xf, axis=-1, keepdims=True)
    var = jnp.mean(xc * xc, axis=-1, keepdims=True)
    return (xc * lax.rsqrt(var + LN_EPS) * g + b).astype(x.dtype)


def rms_norm(x, w):
    xf = x.astype(jnp.float32)
    return (xf * lax.rsqrt(jnp.mean(xf * xf, axis=-1, keepdims=True) + RMS_EPS) * w).astype(x.dtype)


def l2_norm(x):
    xf = x.astype(jnp.float32)
    return xf * lax.rsqrt(jnp.sum(xf * xf, axis=-1, keepdims=True) + RMS_EPS)


def split_last(x, sizes):
    idx = [int(i) for i in np.cumsum(sizes)[:-1]]
    return jnp.split(x, idx, axis=-1)


def to_heads(t, n_heads):
    b, s, w = t.shape
    return t.reshape(b, s, n_heads, w // n_heads).transpose(0, 2, 1, 3)


def flip_seq(t):
    return jnp.flip(t, axis=2)


def centered_depthwise_conv(x, w):
    k, c = w.shape
    return lax.conv_general_dilated(
        x, w[:, None, :].astype(x.dtype), window_strides=(1,), padding=[(k // 2, k // 2)],
        dimension_numbers=('NWC', 'WIO', 'NWC'), feature_group_count=c)


def axial_rope_tables(seq_len):
    rows = seq_len // GRID_W
    row = jnp.repeat(jnp.arange(rows, dtype=jnp.float32), GRID_W)
    col = jnp.tile(jnp.arange(GRID_W, dtype=jnp.float32), rows)
    inv_freq = ROPE_THETA ** (-jnp.arange(0, ROPE_AXIS_DIM, 2, dtype=jnp.float32) / ROPE_AXIS_DIM)
    ang = jnp.stack([row[:, None] * inv_freq, col[:, None] * inv_freq], axis=1)
    return jnp.cos(ang), jnp.sin(ang)


def apply_axial_rope(x, cos, sin):
    xs = x.astype(jnp.float32).reshape(*x.shape[:-1], 2, 2, ROPE_AXIS_DIM // 2)
    x1, x2 = xs[..., 0, :], xs[..., 1, :]
    out = jnp.stack([x1 * cos - x2 * sin, x2 * cos + x1 * sin], axis=-2)
    return out.reshape(x.shape).astype(x.dtype)


def gated_delta_rule(q, k, v, g, beta):
    f32 = jnp.float32
    b, h, s, dk = q.shape
    dv = v.shape[-1]
    c = GDN_CHUNK
    n = s // c
    q = q.astype(f32).reshape(b, h, n, c, dk)
    k = k.astype(f32).reshape(b, h, n, c, dk)
    v = v.astype(f32).reshape(b, h, n, c, dv)
    g = jnp.cumsum(g.astype(f32).reshape(b, h, n, c), axis=-1)
    beta = beta.astype(f32).reshape(b, h, n, c, 1)
    pos = jnp.arange(c)
    incl = pos[:, None] >= pos[None, :]
    strict = pos[:, None] > pos[None, :]
    decay = jnp.exp(jnp.where(incl, g[..., :, None] - g[..., None, :], -jnp.inf))
    k_beta = k * beta
    lower = jnp.where(strict, jnp.einsum('bhnid,bhnjd->bhnij', k_beta, k) * decay, 0.0)
    lhs = lower + jnp.eye(c, dtype=f32)
    rhs = jnp.concatenate([v * beta, k_beta * jnp.exp(g)[..., None]], axis=-1)
    sol = lax.linalg.triangular_solve(lhs, rhs, left_side=True, lower=True)
    u, w = sol[..., :dv], sol[..., dv:]
    attn = jnp.einsum('bhnid,bhnjd->bhnij', q, k) * decay
    q_dec = q * jnp.exp(g)[..., None]
    k_dec = k * jnp.exp(g[..., -1:] - g)[..., None]
    chunk_decay = jnp.exp(g[..., -1])

    def step(state, xs):
        u_n, w_n, attn_n, qd_n, kd_n, cd_n = xs
        v_new = u_n - jnp.einsum('bhcd,bhde->bhce', w_n, state)
        out = (jnp.einsum('bhcd,bhde->bhce', qd_n, state)
               + jnp.einsum('bhij,bhje->bhie', attn_n, v_new))
        state = state * cd_n[..., None, None] + jnp.einsum('bhcd,bhce->bhde', kd_n, v_new)
        return state, out

    xs = tuple(jnp.moveaxis(t, 2, 0) for t in (u, w, attn, q_dec, k_dec, chunk_decay))
    _, out = lax.scan(step, jnp.zeros((b, h, dk, dv), f32), xs)
    return jnp.moveaxis(out, 0, 2).reshape(b, h, s, dv)


def hgrn2_chunked(q, k, v, log_f):
    f32 = jnp.float32
    b, h, s, dk = q.shape
    dv = v.shape[-1]
    c = HGRN_CHUNK
    n = s // c
    q = q.astype(f32).reshape(b, h, n, c, dk)
    k = k.astype(f32).reshape(b, h, n, c, dk)
    v = v.astype(f32).reshape(b, h, n, c, dv)
    cum = jnp.cumsum(log_f.astype(f32).reshape(b, h, n, c, dk), axis=-2)
    q_dec = q * jnp.exp(cum)
    k_dec = k * jnp.exp(cum[..., -1:, :] - cum)
    chunk_decay = jnp.exp(cum[..., -1, :])
    pos = jnp.arange(c)
    incl = (pos[:, None] >= pos[None, :])[:, :, None]

    def step(state, xs):
        q_n, k_n, v_n, cum_n, qd_n, kd_n, cd_n = xs
        rel = jnp.exp(jnp.where(incl, cum_n[..., :, None, :] - cum_n[..., None, :, :], -jnp.inf))
        a = jnp.einsum('bhid,bhjd,bhijd->bhij', q_n, k_n, rel)
        out = (jnp.einsum('bhid,bhde->bhie', qd_n, state)
               + jnp.einsum('bhij,bhje->bhie', a, v_n))
        state = state * cd_n[..., :, None] + jnp.einsum('bhjd,bhje->bhde', kd_n, v_n)
        return state, out

    xs = tuple(jnp.moveaxis(t, 2, 0) for t in (q, k, v, cum, q_dec, k_dec, chunk_decay))
    _, out = lax.scan(step, jnp.zeros((b, h, dk, dv), f32), xs)
    return jnp.moveaxis(out, 0, 2).reshape(b, h, s, dv)


def hgrn_lower_bounds(logits):
    p = jax.nn.softmax(logits.astype(jnp.float32), axis=0)
    cum = jnp.cumsum(p, axis=0)
    return cum - cum[0]


def blocked_bidirectional_gqa(q, k, v):
    b, hq, s, d = q.shape
    hkv = k.shape[1]
    grp = hq // hkv
    nb = s // Q_BLOCK
    qb = q.reshape(b, hkv, grp, nb, Q_BLOCK, d).transpose(3, 0, 1, 2, 4, 5)
    scale = d ** -0.5

    def one_block(qi):
        sc = jnp.einsum('bkgqd,bksd->bkgqs', qi, k).astype(jnp.float32) * scale
        p = jax.nn.softmax(sc, axis=-1).astype(v.dtype)
        return jnp.einsum('bkgqs,bksd->bkgqd', p, v)

    o = lax.map(one_block, qb)
    return o.transpose(1, 0, 4, 2, 3, 5).reshape(b, s, hq * d)


def hybrid_token_mixer(x, rope_cos, rope_sin, w_in, conv_w, a_log, dt_bias, gdn_norm_w,
                       q_norm_w, k_norm_w, lower_bound, hgrn_norm_w, w_out):
    f32 = jnp.float32
    b, s, _ = x.shape
    (a_qkv, a_z, a_beta, a_decay, b_q, b_k, b_v,
     c_f, c_i, c_q, c_g) = split_last(x @ w_in, IN_SPLITS)

    def dir_heads(t):
        return t.astype(f32).reshape(b, s, 2, A_HEADS).transpose(2, 0, 3, 1)

    qkv = jax.nn.silu(centered_depthwise_conv(a_qkv, conv_w))
    aq, ak, av = jnp.split(qkv, 3, axis=-1)
    aq = l2_norm(to_heads(aq, A_HEADS)) * (HEAD_DIM ** -0.5)
    ak = l2_norm(to_heads(ak, A_HEADS))
    av = to_heads(av, A_HEADS)
    beta = jax.nn.sigmoid(dir_heads(a_beta))
    log_decay = (-jnp.exp(a_log.astype(f32))[:, None, :, None]
                 * jax.nn.softplus(dir_heads(a_decay) + dt_bias.astype(f32)[:, None, :, None]))
    oa = gated_delta_rule(aq, ak, av, log_decay[0], beta[0])
    oa = oa + flip_seq(gated_delta_rule(flip_seq(aq), flip_seq(ak), flip_seq(av),
                                        flip_seq(log_decay[1]), flip_seq(beta[1])))
    oa = rms_norm(oa.transpose(0, 2, 1, 3), gdn_norm_w) * jax.nn.silu(
        a_z.astype(f32).reshape(b, s, A_HEADS, HEAD_DIM))
    oa = oa.reshape(b, s, A_WIDTH)

    bq = rms_norm(b_q.reshape(b, s, B_Q_HEADS, HEAD_DIM), q_norm_w).transpose(0, 2, 1, 3)
    bk = rms_norm(b_k.reshape(b, s, B_KV_HEADS, HEAD_DIM), k_norm_w).transpose(0, 2, 1, 3)
    bv = to_heads(b_v, B_KV_HEADS)
    bq = apply_axial_rope(bq, rope_cos, rope_sin)
    bk = apply_axial_rope(bk, rope_cos, rope_sin)
    ob = blocked_bidirectional_gqa(bq, bk, bv)

    lb = lower_bound.astype(f32)
    f_gate = lb + (1.0 - lb) * jax.nn.sigmoid(c_f.astype(f32).reshape(b, s, 2, C_WIDTH))
    log_f = jnp.log(f_gate)
    k_in = 1.0 - f_gate
    cq = to_heads(jax.nn.silu(c_q.astype(f32)), C_HEADS) * (HEAD_DIM ** -0.5)
    ci = to_heads(c_i.astype(f32), C_HEADS)
    oc = hgrn2_chunked(cq, to_heads(k_in[:, :, 0], C_HEADS), ci, to_heads(log_f[:, :, 0], C_HEADS))
    oc = oc + flip_seq(hgrn2_chunked(flip_seq(cq), flip_seq(to_heads(k_in[:, :, 1], C_HEADS)),
                                     flip_seq(ci), flip_seq(to_heads(log_f[:, :, 1], C_HEADS))))
    oc = rms_norm(oc.transpose(0, 2, 1, 3), hgrn_norm_w) * jax.nn.sigmoid(
        c_g.astype(f32).reshape(b, s, C_HEADS, HEAD_DIM))
    oc = oc.reshape(b, s, C_WIDTH)

    mixed = jnp.concatenate([oa.astype(x.dtype), ob.astype(x.dtype), oc.astype(x.dtype)], axis=-1)
    return mixed @ w_out


def memory_cross_attention(x, mem, wq, wk, wv, wo):
    b, s, _ = x.shape
    m = mem.shape[1]
    q = (x @ wq).reshape(b, s, X_HEADS, X_HEAD_DIM)
    k = (mem @ wk).reshape(b, m, X_HEADS, X_HEAD_DIM)
    v = (mem @ wv).reshape(b, m, X_HEADS, X_HEAD_DIM)
    sc = jnp.einsum('bshd,bmhd->bhsm', q, k).astype(jnp.float32) * (X_HEAD_DIM ** -0.5)
    p = jax.nn.softmax(sc, axis=-1).astype(v.dtype)
    o = jnp.einsum('bhsm,bmhd->bshd', p, v).reshape(b, s, X_HEADS * X_HEAD_DIM)
    return o @ wo


def swiglu(x, wg, wu, wd):
    return (jax.nn.silu(x @ wg) * (x @ wu)) @ wd


def moe_swiglu(x, w_router, w_gate, w_up, w_down):
    b, s, d = x.shape
    n = b * s
    xt = x.reshape(n, d)
    logits = (xt @ w_router).astype(jnp.float32)
    top_logit, top_e = lax.top_k(logits, TOP_K)
    top_w = jax.nn.softmax(top_logit, axis=-1)
    flat_e = top_e.reshape(-1)
    flat_tok = jnp.repeat(jnp.arange(n, dtype=jnp.int32), TOP_K)
    flat_w = top_w.reshape(-1)
    order = jnp.argsort(flat_e)
    e_sorted = flat_e[order]
    counts = jnp.bincount(flat_e, length=N_EXPERTS)
    padded = (counts + MOE_BLOCK - 1) // MOE_BLOCK * MOE_BLOCK
    pad_end = jnp.cumsum(padded)
    pad_start = pad_end - padded
    start = jnp.cumsum(counts) - counts
    dest = pad_start[e_sorted] + jnp.arange(n * TOP_K, dtype=jnp.int32) - start[e_sorted]
    n_rows = n * TOP_K + N_EXPERTS * MOE_BLOCK
    n_blocks = n_rows // MOE_BLOCK
    row_tok = jnp.zeros((n_rows,), jnp.int32).at[dest].set(flat_tok[order])
    row_w = jnp.zeros((n_rows,), jnp.float32).at[dest].set(flat_w[order])
    block_e = jnp.minimum(
        jnp.searchsorted(pad_end, jnp.arange(n_blocks, dtype=jnp.int32) * MOE_BLOCK, side='right'),
        N_EXPERTS - 1)
    xb = xt[row_tok].reshape(n_blocks, MOE_BLOCK, d)

    def expert_block(args):
        xs, e = args
        hdn = jax.nn.silu(xs @ w_gate[e]) * (xs @ w_up[e])
        return hdn @ w_down[e]

    yb = lax.map(expert_block, (xb, block_e)).reshape(n_rows, d)
    y = jnp.zeros((n, d), jnp.float32).at[row_tok].add(yb.astype(jnp.float32) * row_w[:, None])
    return y.astype(x.dtype).reshape(b, s, d)


def setup_inputs(seed: int = 0) -> dict:
    key = jax.random.key(seed)
    keys = iter(jax.random.split(key, 40))
    f32 = jnp.float32
    L = DEPTH

    def normal(shape, scale):
        return jax.random.normal(next(keys), shape, f32) * scale

    def gain(shape):
        return 1.0 + normal(shape, 0.02)

    x = normal((BATCH, SEQ, D_MODEL), 1.0)
    mem = normal((BATCH, MEM_TOKENS, D_MODEL), 1.0)
    w_in = normal((L, D_MODEL, D_IN), D_MODEL ** -0.5)
    conv_w = normal((L, CONV_K, 3 * A_WIDTH), CONV_K ** -0.5)
    gdn_a_log = jnp.log(jax.random.uniform(next(keys), (L, 2, A_HEADS), f32, 1.0, 16.0))
    dt = jnp.exp(jax.random.uniform(next(keys), (L, 2, A_HEADS), f32, math.log(1e-3), math.log(1e-1)))
    gdn_dt_bias = dt + jnp.log(-jnp.expm1(-dt))
    gdn_norm_w = gain((L, HEAD_DIM))
    q_norm_w = gain((L, HEAD_DIM))
    k_norm_w = gain((L, HEAD_DIM))
    hgrn_lb_logits = normal((L, C_WIDTH), 0.1)
    hgrn_norm_w = gain((L, HEAD_DIM))
    w_out = normal((L, D_MIX, D_MODEL), D_MIX ** -0.5 * DN_BETA)
    ln1_g = gain((L, D_MODEL))
    ln1_b = normal((L, D_MODEL), 0.02)
    xq = normal((L, D_MODEL, X_HEADS * X_HEAD_DIM), D_MODEL ** -0.5)
    xk = normal((L, D_MODEL, X_HEADS * X_HEAD_DIM), D_MODEL ** -0.5)
    xv = normal((L, D_MODEL, X_HEADS * X_HEAD_DIM), D_MODEL ** -0.5)
    xo = normal((L, X_HEADS * X_HEAD_DIM, D_MODEL), (X_HEADS * X_HEAD_DIM) ** -0.5 * DN_BETA)
    ln2_g = gain((L, D_MODEL))
    ln2_b = normal((L, D_MODEL), 0.02)
    ffn_wg = normal((N_DENSE, D_MODEL, D_FF), D_MODEL ** -0.5)
    ffn_wu = normal((N_DENSE, D_MODEL, D_FF), D_MODEL ** -0.5)
    ffn_wd = normal((N_DENSE, D_FF, D_MODEL), D_FF ** -0.5 * DN_BETA)
    moe_router = normal((N_MOE, D_MODEL, N_EXPERTS), D_MODEL ** -0.5)
    moe_wg = normal((N_MOE, N_EXPERTS, D_MODEL, D_FF_EXPERT), D_MODEL ** -0.5)
    moe_wu = normal((N_MOE, N_EXPERTS, D_MODEL, D_FF_EXPERT), D_MODEL ** -0.5)
    moe_wd = normal((N_MOE, N_EXPERTS, D_FF_EXPERT, D_MODEL), D_FF_EXPERT ** -0.5 * DN_BETA)
    ln3_g = gain((L, D_MODEL))
    ln3_b = normal((L, D_MODEL), 0.02)
    return {'x': x, 'mem': mem, 'w_in': w_in, 'conv_w': conv_w, 'gdn_a_log': gdn_a_log,
            'gdn_dt_bias': gdn_dt_bias, 'gdn_norm_w': gdn_norm_w, 'q_norm_w': q_norm_w,
            'k_norm_w': k_norm_w, 'hgrn_lb_logits': hgrn_lb_logits, 'hgrn_norm_w': hgrn_norm_w,
            'w_out': w_out, 'ln1_g': ln1_g, 'ln1_b': ln1_b, 'xq': xq, 'xk': xk, 'xv': xv, 'xo': xo,
            'ln2_g': ln2_g, 'ln2_b': ln2_b, 'ffn_wg': ffn_wg, 'ffn_wu': ffn_wu, 'ffn_wd': ffn_wd,
            'moe_router': moe_router, 'moe_wg': moe_wg, 'moe_wu': moe_wu, 'moe_wd': moe_wd,
            'ln3_g': ln3_g, 'ln3_b': ln3_b}


def reference(x, mem, w_in, conv_w, gdn_a_log, gdn_dt_bias, gdn_norm_w, q_norm_w, k_norm_w,
              hgrn_lb_logits, hgrn_norm_w, w_out, ln1_g, ln1_b, xq, xk, xv, xo, ln2_g, ln2_b,
              ffn_wg, ffn_wu, ffn_wd, moe_router, moe_wg, moe_wu, moe_wd, ln3_g, ln3_b):
    seq_len = x.shape[1]
    rope_cos, rope_sin = axial_rope_tables(seq_len)
    lower_bounds = hgrn_lower_bounds(hgrn_lb_logits)
    for l in range(DEPTH):
        h = hybrid_token_mixer(x, rope_cos, rope_sin, w_in[l], conv_w[l], gdn_a_log[l], gdn_dt_bias[l],
                               gdn_norm_w[l], q_norm_w[l], k_norm_w[l], lower_bounds[l],
                               hgrn_norm_w[l], w_out[l])
        x = layer_norm(DN_ALPHA * x + h, ln1_g[l], ln1_b[l])
        c = memory_cross_attention(x, mem, xq[l], xk[l], xv[l], xo[l])
        x = layer_norm(DN_ALPHA * x + c, ln2_g[l], ln2_b[l])
        if l % 2 == 0:
            f = swiglu(x, ffn_wg[l // 2], ffn_wu[l // 2], ffn_wd[l // 2])
        else:
            f = moe_swiglu(x, moe_router[l // 2], moe_wg[l // 2], moe_wu[l // 2], moe_wd[l // 2])
        x = layer_norm(DN_ALPHA * x + f, ln3_g[l], ln3_b[l])
    return x
```

```cpp
#define MULTI_LAUNCH 1
#ifndef CPU_TEST
#include <hip/hip_runtime.h>
#include <hip/hip_cooperative_groups.h>
#include <cstdio>
#include <cstdint>
#define DEV __device__ __forceinline__
#define HD __host__ __device__ __forceinline__
#else
#include <cstdio>
#include <cstdint>
#include <cstring>
#include <cmath>
#define DEV inline
#define HD inline
#endif

#ifndef CFG_D
#define CFG_D 1024
#define CFG_B 4
#define CFG_S 4096
#define CFG_MEM 256
#define CFG_FF 2816
#define CFG_FFE 3584
#endif
constexpr int D = CFG_D, NB = CFG_B, S = CFG_S, NTOK = NB * S, MEMT = CFG_MEM, FF = CFG_FF, FFE = CFG_FFE;
constexpr int XH = 4, XHD = D / XH, NMEM = NB * MEMT;
constexpr int DIN = 3480, DINP = 3584, MIXW = 1024;
constexpr int NEXP = 8;
constexpr int MOE_TMAX = 2 * NTOK / 256 + NEXP, MOE_THALF = (MOE_TMAX + 1) / 2, MOE_ROWS = MOE_TMAX * 256;
constexpr int C_AQKV = 0, C_AZ = 1152, C_ABETA = 1536, C_ADECAY = 1548, C_BQ = 1560, C_BK = 1944, C_BV = 2072, C_CF = 2200, C_CI = 2712, C_CQ = 2968, C_CG = 3224;
constexpr float DN_ALPHA = 1.41421356237309515f;
constexpr float LN_EPS = 1e-5f, RMS_EPS = 1e-6f;
constexpr float LOG2E = 1.4426950408889634f;

typedef unsigned short bf16_t;
typedef float f32x4 __attribute__((ext_vector_type(4)));
typedef unsigned u32x4 __attribute__((ext_vector_type(4)));
typedef unsigned u32x2 __attribute__((ext_vector_type(2)));

DEV float bf2f(bf16_t h) { unsigned u = (unsigned)h << 16; float f; __builtin_memcpy(&f, &u, 4); return f; }
DEV bf16_t f2bf(float f) { unsigned u; __builtin_memcpy(&u, &f, 4); return (bf16_t)((u + 0x7fffu + ((u >> 16) & 1u)) >> 16); }
DEV unsigned pk2(float lo, float hi) { return (unsigned)f2bf(lo) | ((unsigned)f2bf(hi) << 16); }
DEV float sigmoidf_(float x) { return 1.0f / (1.0f + expf(-x)); }
DEV float siluf_(float x) { return x / (1.0f + expf(-x)); }
DEV float softplusf_(float x) { return x > 20.f ? x : log1pf(expf(x)); }

enum { I_X = 0, I_MEM, I_WIN, I_CONVW, I_ALOG, I_DTB, I_GDNNW, I_QNW, I_KNW, I_LBL, I_HGNW, I_WOUT, I_LN1G, I_LN1B, I_XQ, I_XK, I_XV, I_XO,
       I_LN2G, I_LN2B, I_FWG, I_FWU, I_FWD, I_ROUTER, I_MWG, I_MWU, I_MWD, I_LN3G, I_LN3B, N_IN };
struct Params { const float* in[N_IN]; float* out; unsigned char* ws; int lo, hi; };
#ifdef CPU_TEST
typedef const Params* KargPtr;
#else
typedef const __attribute__((address_space(4))) Params* KargPtr;
#endif
struct PRef { KargPtr k; };

constexpr size_t al256(size_t x) { return (x + 255) & ~(size_t)255; }
constexpr size_t O_CTL = 0;
constexpr size_t O_LB = 4096;
constexpr size_t O_ROPE = O_LB + 2 * 256 * 4;
constexpr size_t O_TOPE = al256(O_ROPE + 64 * 16 * 2 * 4);
constexpr size_t O_TOPW = O_TOPE + (size_t)NTOK * 8;
constexpr size_t O_POSE = O_TOPW + (size_t)NTOK * 8;
constexpr size_t O_WIN_T = al256(O_POSE + (size_t)NTOK * 8);
constexpr size_t O_WOUT_T = O_WIN_T + (size_t)2 * DINP * D * 2;
constexpr size_t O_XQ_T = O_WOUT_T + (size_t)2 * D * MIXW * 2;
constexpr size_t O_XO_T = O_XQ_T + (size_t)2 * D * D * 2;
constexpr size_t O_XKV_T = O_XO_T + (size_t)2 * D * D * 2;
constexpr size_t O_FGU_T = O_XKV_T + (size_t)2 * 2 * D * D * 2;
constexpr size_t O_FD_T = O_FGU_T + (size_t)2 * FF * D * 2;
constexpr size_t O_MEMB = O_FD_T + (size_t)D * FF * 2;
constexpr size_t O_KMEM = O_MEMB + (size_t)NMEM * D * 2;
constexpr size_t O_VT = O_KMEM + (size_t)2 * NMEM * D * 2;
constexpr size_t O_XB = O_VT + (size_t)2 * NMEM * D * 2;
constexpr size_t O_R0 = al256(O_XB + (size_t)NTOK * D * 2);
constexpr size_t O_PROJ = O_R0;
constexpr size_t O_AQ = O_PROJ + (size_t)NTOK * DINP * 2;
constexpr size_t O_AK = O_AQ + (size_t)NTOK * 384 * 2;
constexpr size_t O_AV = O_AK + (size_t)NTOK * 384 * 2;
constexpr size_t O_QB = O_AV + (size_t)NTOK * 384 * 2;
constexpr size_t O_KB = O_QB + (size_t)NTOK * 384 * 2;
constexpr size_t O_KIN = O_KB + (size_t)NTOK * 128 * 2;
constexpr size_t O_CQ = O_KIN + (size_t)2 * NTOK * 256 * 2;
constexpr size_t O_OA = O_CQ + (size_t)NTOK * 256 * 2;
constexpr size_t O_OC = O_OA + (size_t)2 * NTOK * 384 * 4;
constexpr size_t O_MIXED = O_OC + (size_t)2 * NTOK * 256 * 4;
constexpr size_t O_BETA = O_MIXED + (size_t)NTOK * 1024 * 2;
constexpr size_t O_GG = O_BETA + (size_t)2 * NTOK * 6 * 4;
constexpr size_t O_QX = al256(O_GG + (size_t)2 * NTOK * 6 * 4);
constexpr size_t O_MIX_END = O_QX + (size_t)NTOK * D * 2;
constexpr size_t O_HID = O_R0;
constexpr size_t O_MGU_T = O_R0;
constexpr size_t O_MD_T = O_MGU_T + (size_t)NEXP * 2 * FFE * D * 2;
constexpr size_t O_XG = O_MD_T + (size_t)NEXP * D * FFE * 2;
constexpr size_t O_HIDM = O_XG + (size_t)MOE_ROWS * D * 2;
constexpr size_t O_MOE_END = O_HIDM + (size_t)MOE_THALF * 256 * FFE * 2;
constexpr size_t WS_TOTAL = O_MIX_END > O_MOE_END ? O_MIX_END : O_MOE_END;
static_assert(O_HID + (size_t)NTOK * FF * 2 <= WS_TOTAL, "ws map");
struct Ctx { int gtid, gsz; };
#ifdef CPU_TEST
#define FENCE() do {} while (0)
#else
#define FENCE() asm volatile("" ::: "memory")
#endif
#define WSP(T, off) ((T*)(p.k->ws + (off)))

DEV void cvt_wt(const Ctx& c, const float* W, int K, int N, bf16_t* WT, int mode, int row_off) {
    const size_t items = (size_t)(K / 8) * N;
    for (size_t it = c.gtid; it < items; it += c.gsz) {
        const int n = (int)(it % N), k0 = (int)(it / N) * 8;
        const int row = mode == 0 ? row_off + n : (n >> 7) * 256 + (mode == 2 ? 128 : 0) + (n & 127);
        u32x4 o;
        o.x = pk2(W[(size_t)(k0 + 0) * N + n], W[(size_t)(k0 + 1) * N + n]); o.y = pk2(W[(size_t)(k0 + 2) * N + n], W[(size_t)(k0 + 3) * N + n]);
        o.z = pk2(W[(size_t)(k0 + 4) * N + n], W[(size_t)(k0 + 5) * N + n]); o.w = pk2(W[(size_t)(k0 + 6) * N + n], W[(size_t)(k0 + 7) * N + n]);
        *(u32x4*)(WT + (size_t)row * K + k0) = o;
    }
}
DEV void cvt_rows(const Ctx& c, const float* X, bf16_t* Y, size_t n) {
    for (size_t i = c.gtid; i < n / 4; i += c.gsz) { const f32x4 v = *(const f32x4*)(X + 4 * i); u32x2 o; o.x = pk2(v[0], v[1]); o.y = pk2(v[2], v[3]); *(u32x2*)(Y + 4 * i) = o; }
}
DEV void ph_prologue(const PRef p, const Ctx& c) {
    unsigned* ctl = WSP(unsigned, O_CTL);
    for (int i = c.gtid; i < 1024; i += c.gsz) ctl[i] = 0u;
    float* lb = WSP(float, O_LB);
    for (int i = c.gtid; i < 256; i += c.gsz) { const float l0 = p.k->in[I_LBL][i], l1 = p.k->in[I_LBL][256 + i]; lb[i] = 0.f; lb[256 + i] = 1.0f / (1.0f + expf(l0 - l1)); }
    float* rope = WSP(float, O_ROPE);
    for (int i = c.gtid; i < 64 * 16; i += c.gsz) { const int pos = i >> 4, f = i & 15; const float inv = exp2f(-(float)f * (13.287712379549449f / 16.0f)), a = (float)pos * inv;
        rope[2 * i] = cosf(a); rope[2 * i + 1] = sinf(a); }
    cvt_rows(c, p.k->in[I_X], WSP(bf16_t, O_XB), (size_t)NTOK * D);
    cvt_rows(c, p.k->in[I_MEM], WSP(bf16_t, O_MEMB), (size_t)NMEM * D);
    for (int l = 0; l < 2; ++l) {
        bf16_t* wi = WSP(bf16_t, O_WIN_T) + (size_t)l * DINP * D;
        cvt_wt(c, p.k->in[I_WIN] + (size_t)l * D * DIN, D, DIN, wi, 0, 0);
        for (size_t i = c.gtid; i < (size_t)(DINP - DIN) * D / 8; i += c.gsz) *(u32x4*)(wi + (size_t)DIN * D + 8 * i) = (u32x4){0u, 0u, 0u, 0u};
        cvt_wt(c, p.k->in[I_WOUT] + (size_t)l * MIXW * D, MIXW, D, WSP(bf16_t, O_WOUT_T) + (size_t)l * D * MIXW, 0, 0);
        cvt_wt(c, p.k->in[I_XQ] + (size_t)l * D * D, D, D, WSP(bf16_t, O_XQ_T) + (size_t)l * D * D, 0, 0);
        cvt_wt(c, p.k->in[I_XO] + (size_t)l * D * D, D, D, WSP(bf16_t, O_XO_T) + (size_t)l * D * D, 0, 0);
        cvt_wt(c, p.k->in[I_XK] + (size_t)l * D * D, D, D, WSP(bf16_t, O_XKV_T) + (size_t)l * 2 * D * D, 0, 0);
        cvt_wt(c, p.k->in[I_XV] + (size_t)l * D * D, D, D, WSP(bf16_t, O_XKV_T) + (size_t)l * 2 * D * D, 0, D);
    }
    cvt_wt(c, p.k->in[I_FWG], D, FF, WSP(bf16_t, O_FGU_T), 1, 0);
    cvt_wt(c, p.k->in[I_FWU], D, FF, WSP(bf16_t, O_FGU_T), 2, 0);
    cvt_wt(c, p.k->in[I_FWD], FF, D, WSP(bf16_t, O_FD_T), 0, 0);
}
DEV void ph_moe_weights(const PRef p, const Ctx& c) {
    for (int e = 0; e < NEXP; ++e) {
        cvt_wt(c, p.k->in[I_MWG] + (size_t)e * D * FFE, D, FFE, WSP(bf16_t, O_MGU_T) + (size_t)e * 2 * FFE * D, 1, 0);
        cvt_wt(c, p.k->in[I_MWU] + (size_t)e * D * FFE, D, FFE, WSP(bf16_t, O_MGU_T) + (size_t)e * 2 * FFE * D, 2, 0);
        cvt_wt(c, p.k->in[I_MWD] + (size_t)e * FFE * D, FFE, D, WSP(bf16_t, O_MD_T) + (size_t)e * D * FFE, 0, 0);
    }
}

DEV void conv8(const bf16_t* proj, const float* cw, int n, int t, int ch, float (&v)[8]) {
#pragma unroll
    for (int i = 0; i < 8; ++i) v[i] = 0.f;
#pragma unroll
    for (int j = 0; j < 5; ++j) { const int tt = t + j - 2;
        if (tt >= 0 && tt < S) { const u32x4 q = *(const u32x4*)(proj + (size_t)(n + j - 2) * DINP + C_AQKV + ch); const f32x4 w0 = *(const f32x4*)(cw + j * 1152 + ch), w1 = *(const f32x4*)(cw + j * 1152 + ch + 4);
            v[0] += bf2f((bf16_t)(q[0] & 0xffffu)) * w0[0]; v[1] += bf2f((bf16_t)(q[0] >> 16)) * w0[1]; v[2] += bf2f((bf16_t)(q[1] & 0xffffu)) * w0[2]; v[3] += bf2f((bf16_t)(q[1] >> 16)) * w0[3];
            v[4] += bf2f((bf16_t)(q[2] & 0xffffu)) * w1[0]; v[5] += bf2f((bf16_t)(q[2] >> 16)) * w1[1]; v[6] += bf2f((bf16_t)(q[3] & 0xffffu)) * w1[2]; v[7] += bf2f((bf16_t)(q[3] >> 16)) * w1[3]; } }
#pragma unroll
    for (int i = 0; i < 8; ++i) v[i] = siluf_(v[i]);
}
DEV void ph_prep(const PRef p, int l, const Ctx& c) {
    const bf16_t* proj = WSP(const bf16_t, O_PROJ);
#ifndef NO_PREP_A
    {
        const float* cw = p.k->in[I_CONVW] + (size_t)l * 5 * 1152;
        for (int it = c.gtid; it < NTOK * 18; it += c.gsz) {
            const int n = it / 18, r = it % 18, h = r % 6, part = r / 6, t = n % S, ch0 = part * 384 + h * 64;
            float sc = 1.f;
            if (part < 2) { float ss = 0.f;
                for (int i = 0; i < 64; i += 8) { float v[8]; conv8(proj, cw, n, t, ch0 + i, v);
#pragma unroll
                    for (int e = 0; e < 8; ++e) ss += v[e] * v[e]; }
                sc = 1.0f / sqrtf(ss + RMS_EPS); if (part == 0) sc *= 0.125f; }
            bf16_t* dst = (part == 0 ? WSP(bf16_t, O_AQ) : part == 1 ? WSP(bf16_t, O_AK) : WSP(bf16_t, O_AV)) + (size_t)n * 384 + h * 64;
            for (int i = 0; i < 64; i += 8) { float v[8]; conv8(proj, cw, n, t, ch0 + i, v);
                u32x4 o; o.x = pk2(v[0] * sc, v[1] * sc); o.y = pk2(v[2] * sc, v[3] * sc); o.z = pk2(v[4] * sc, v[5] * sc); o.w = pk2(v[6] * sc, v[7] * sc); *(u32x4*)(dst + i) = o; }
        }
        float* beta = WSP(float, O_BETA); float* gg = WSP(float, O_GG);
        for (int it = c.gtid; it < 2 * NTOK * 6; it += c.gsz) {
            const int dir = it / (NTOK * 6), r = it % (NTOK * 6), n = r / 6, h = r % 6;
            const float xb_ = bf2f(proj[(size_t)n * DINP + C_ABETA + dir * 6 + h]), xd = bf2f(proj[(size_t)n * DINP + C_ADECAY + dir * 6 + h]);
            beta[it] = sigmoidf_(xb_);
            gg[it] = -expf(p.k->in[I_ALOG][l * 12 + dir * 6 + h]) * softplusf_(xd + p.k->in[I_DTB][l * 12 + dir * 6 + h]);
        }
    }
#endif
#ifndef NO_PREP_B
    {
        const float* rope = WSP(const float, O_ROPE);
        for (int it = c.gtid; it < NTOK * 8; it += c.gsz) {
            const int n = it >> 3, j = it & 7, t = n % S;
            const bf16_t* src = proj + (size_t)n * DINP + (j < 6 ? C_BQ + j * 64 : C_BK + (j - 6) * 64);
            const float* nw = (j < 6 ? p.k->in[I_QNW] : p.k->in[I_KNW]) + l * 64;
            float ss = 0.f;
#pragma unroll
            for (int i = 0; i < 64; i += 8) { const u32x4 q = *(const u32x4*)(src + i);
#pragma unroll
                for (int e = 0; e < 4; ++e) { const float x0 = bf2f((bf16_t)(q[e] & 0xffffu)), x1 = bf2f((bf16_t)(q[e] >> 16)); ss += x0 * x0 + x1 * x1; } }
            const float rs = 1.0f / sqrtf(ss * (1.0f / 64.0f) + RMS_EPS) * ((j < 6) ? 0.125f * LOG2E : 1.0f);
            bf16_t* dst = j < 6 ? WSP(bf16_t, O_QB) + (size_t)n * 384 + j * 64 : WSP(bf16_t, O_KB) + (size_t)n * 128 + (j - 6) * 64;
            for (int a = 0; a < 2; ++a) { const int pos = a == 0 ? t / 64 : t % 64; float v[32];
#pragma unroll
                for (int i = 0; i < 32; i += 8) { const u32x4 q = *(const u32x4*)(src + a * 32 + i); const f32x4 w0 = *(const f32x4*)(nw + a * 32 + i), w1 = *(const f32x4*)(nw + a * 32 + i + 4);
                    v[i] = bf2f((bf16_t)(q[0] & 0xffffu)) * w0[0]; v[i + 1] = bf2f((bf16_t)(q[0] >> 16)) * w0[1]; v[i + 2] = bf2f((bf16_t)(q[1] & 0xffffu)) * w0[2]; v[i + 3] = bf2f((bf16_t)(q[1] >> 16)) * w0[3];
                    v[i + 4] = bf2f((bf16_t)(q[2] & 0xffffu)) * w1[0]; v[i + 5] = bf2f((bf16_t)(q[2] >> 16)) * w1[1]; v[i + 6] = bf2f((bf16_t)(q[3] & 0xffffu)) * w1[2]; v[i + 7] = bf2f((bf16_t)(q[3] >> 16)) * w1[3]; }
#pragma unroll
                for (int i = 0; i < 16; ++i) { const float cs = rope[(pos * 16 + i) * 2] * rs, sn = rope[(pos * 16 + i) * 2 + 1] * rs; const float x1 = v[i], x2 = v[16 + i];
                    v[i] = x1 * cs - x2 * sn; v[16 + i] = x2 * cs + x1 * sn; }
#pragma unroll
                for (int i = 0; i < 32; i += 8) { u32x4 w; w.x = pk2(v[i], v[i + 1]); w.y = pk2(v[i + 2], v[i + 3]); w.z = pk2(v[i + 4], v[i + 5]); w.w = pk2(v[i + 6], v[i + 7]); *(u32x4*)(dst + a * 32 + i) = w; } }
        }
    }
#endif
#ifndef NO_PREP_C
    {
        const float* lb = WSP(const float, O_LB) + l * 256; bf16_t* kin = WSP(bf16_t, O_KIN); bf16_t* cq = WSP(bf16_t, O_CQ);
        for (int it = c.gtid; it < NTOK * 256; it += c.gsz) {
            const int n = it >> 8, ch = it & 255; const bf16_t* row = proj + (size_t)n * DINP;
            const float om = 1.0f - lb[ch];
            kin[(size_t)n * 256 + ch] = f2bf(om * sigmoidf_(-bf2f(row[C_CF + ch])));
            kin[(size_t)(NTOK + n) * 256 + ch] = f2bf(om * sigmoidf_(-bf2f(row[C_CF + 256 + ch])));
            cq[it] = f2bf(siluf_(bf2f(row[C_CQ + ch])) * 0.125f);
        }
    }
#endif
}

DEV void ph_attn_naive(const PRef p, const Ctx& c) {
    const bf16_t* Q = WSP(const bf16_t, O_QB); const bf16_t* Kb = WSP(const bf16_t, O_KB); const bf16_t* proj = WSP(const bf16_t, O_PROJ); bf16_t* mixed = WSP(bf16_t, O_MIXED);
    for (int it = c.gtid; it < NB * 6 * S; it += c.gsz) {
        const int t = it % S, hq = (it / S) % 6, b = it / (6 * S), kv = hq / 3, n = b * S + t;
        float q[64], acc[64];
#pragma unroll
        for (int i = 0; i < 64; ++i) { q[i] = bf2f(Q[(size_t)n * 384 + hq * 64 + i]); acc[i] = 0.f; }
        float m = -1e30f, lsum = 0.f;
        for (int s2 = 0; s2 < S; ++s2) {
            const bf16_t* kr = Kb + (size_t)(b * S + s2) * 128 + kv * 64; const bf16_t* vr = proj + (size_t)(b * S + s2) * DINP + C_BV + kv * 64;
            float sc = 0.f;
#pragma unroll
            for (int i = 0; i < 64; ++i) sc += q[i] * bf2f(kr[i]);
            FENCE();
            if (sc > m) { const float f = exp2f(m - sc); lsum *= f;
#pragma unroll
                for (int i = 0; i < 64; ++i) acc[i] *= f;
                m = sc; }
            const float pe = exp2f(sc - m); lsum += pe;
#pragma unroll
            for (int i = 0; i < 64; ++i) acc[i] += pe * bf2f(vr[i]);
        }
        const float inv = 1.0f / lsum;
#pragma unroll
        for (int i = 0; i < 64; ++i) mixed[(size_t)n * 1024 + 384 + hq * 64 + i] = f2bf(acc[i] * inv);
    }
}
DEV void ph_gdn_naive(const PRef p, const Ctx& c) {
    const bf16_t* AQ = WSP(const bf16_t, O_AQ); const bf16_t* AK = WSP(const bf16_t, O_AK); const bf16_t* AV = WSP(const bf16_t, O_AV);
    const float* beta = WSP(const float, O_BETA); const float* gg = WSP(const float, O_GG); float* OA = WSP(float, O_OA);
    for (int it = c.gtid; it < 2 * NB * 6 * 64; it += c.gsz) {
        const int e = it & 63, h = (it >> 6) % 6, b = (it / 384) % NB, dir = it / (384 * NB);
        float st[64];
#pragma unroll
        for (int i = 0; i < 64; ++i) st[i] = 0.f;
        for (int s2 = 0; s2 < S; ++s2) {
            const int t = dir == 0 ? s2 : S - 1 - s2, n = b * S + t;
            const float a = expf(gg[((size_t)dir * NTOK + n) * 6 + h]), be = beta[((size_t)dir * NTOK + n) * 6 + h];
            const bf16_t* kr = AK + (size_t)n * 384 + h * 64; const bf16_t* qr = AQ + (size_t)n * 384 + h * 64;
            float kk[64]; float pr = 0.f;
#pragma unroll
            for (int i = 0; i < 64; ++i) { kk[i] = bf2f(kr[i]); pr += kk[i] * st[i]; }
            const float vn = be * (bf2f(AV[(size_t)n * 384 + h * 64 + e]) - a * pr);
            float o = 0.f;
#pragma unroll
            for (int i = 0; i < 64; ++i) { st[i] = a * st[i] + kk[i] * vn; o += st[i] * bf2f(qr[i]); }
            OA[((size_t)dir * NTOK + n) * 384 + h * 64 + e] = o;
        }
    }
}
DEV void ph_hgrn_naive(const PRef p, const Ctx& c) {
    const bf16_t* KIN = WSP(const bf16_t, O_KIN); const bf16_t* CQ = WSP(const bf16_t, O_CQ); const bf16_t* proj = WSP(const bf16_t, O_PROJ); float* OC = WSP(float, O_OC);
    for (int it = c.gtid; it < 2 * NB * 4 * 64; it += c.gsz) {
        const int e = it & 63, h = (it >> 6) % 4, b = (it / 256) % NB, dir = it / (256 * NB);
        float st[64];
#pragma unroll
        for (int i = 0; i < 64; ++i) st[i] = 0.f;
        for (int s2 = 0; s2 < S; ++s2) {
            const int t = dir == 0 ? s2 : S - 1 - s2, n = b * S + t;
            const bf16_t* kr = KIN + ((size_t)dir * NTOK + n) * 256 + h * 64; const bf16_t* qr = CQ + (size_t)n * 256 + h * 64;
            const float v = bf2f(proj[(size_t)n * DINP + C_CI + h * 64 + e]);
            float o = 0.f;
#pragma unroll
            for (int i = 0; i < 64; ++i) { const float k = bf2f(kr[i]); st[i] = (1.0f - k) * st[i] + k * v; o += st[i] * bf2f(qr[i]); }
            OC[((size_t)dir * NTOK + n) * 256 + h * 64 + e] = o;
        }
    }
}
DEV void ph_combine(const PRef p, int l, const Ctx& c) {
    const bf16_t* proj = WSP(const bf16_t, O_PROJ); const float* OA = WSP(const float, O_OA); const float* OC = WSP(const float, O_OC); bf16_t* mixed = WSP(bf16_t, O_MIXED);
    for (int it = c.gtid; it < NTOK * 10; it += c.gsz) {
        const int n = it / 10, j = it % 10; const bool isA = j < 6; const int h = isA ? j : j - 6;
        const float* s0 = isA ? OA + (size_t)n * 384 + h * 64 : OC + (size_t)n * 256 + h * 64;
        const float* s1 = isA ? s0 + (size_t)NTOK * 384 : s0 + (size_t)NTOK * 256;
        const float* nw = (isA ? p.k->in[I_GDNNW] : p.k->in[I_HGNW]) + l * 64;
        const bf16_t* gate = proj + (size_t)n * DINP + (isA ? C_AZ : C_CG) + h * 64;
        float v[64]; float ss = 0.f;
#pragma unroll
        for (int i = 0; i < 64; i += 4) { const f32x4 a = *(const f32x4*)(s0 + i), b2 = *(const f32x4*)(s1 + i);
#pragma unroll
            for (int e = 0; e < 4; ++e) { v[i + e] = a[e] + b2[e]; ss += v[i + e] * v[i + e]; } }
        const float rs = 1.0f / sqrtf(ss * (1.0f / 64.0f) + RMS_EPS);
        bf16_t* dst = mixed + (size_t)n * 1024 + (isA ? 0 : 768) + h * 64;
#pragma unroll
        for (int i = 0; i < 64; i += 2) { const float g0 = bf2f(gate[i]), g1 = bf2f(gate[i + 1]);
            const float a0 = isA ? siluf_(g0) : sigmoidf_(g0), a1 = isA ? siluf_(g1) : sigmoidf_(g1);
            *(unsigned*)(dst + i) = pk2(v[i] * rs * nw[i] * a0, v[i + 1] * rs * nw[i + 1] * a1); }
    }
}
DEV void ph_xattn_naive(const PRef p, int l, const Ctx& c) {
    const bf16_t* QX = WSP(const bf16_t, O_QX); const bf16_t* KM = WSP(const bf16_t, O_KMEM) + (size_t)l * NMEM * D; const bf16_t* VT = WSP(const bf16_t, O_VT) + (size_t)l * NMEM * D;
    bf16_t* OX = WSP(bf16_t, O_MIXED);
    constexpr int QW = XHD / 4;
    for (int it = c.gtid; it < NTOK * XH * 4; it += c.gsz) {
        const int part = it & 3, h = (it >> 2) % XH, n = it / (4 * XH), b = n / S;
        const bf16_t* qr = QX + (size_t)n * D + h * XHD;
        float acc[QW];
#pragma unroll
        for (int i = 0; i < QW; ++i) acc[i] = 0.f;
        float m = -1e30f, lsum = 0.f;
        for (int k = 0; k < MEMT; ++k) {
            const bf16_t* kr = KM + (size_t)(b * MEMT + k) * D + h * XHD;
            float sc = 0.f;
            for (int i = 0; i < XHD; ++i) sc += bf2f(qr[i]) * bf2f(kr[i]);
            if (sc > m) { const float f = exp2f(m - sc); lsum *= f;
#pragma unroll
                for (int i = 0; i < QW; ++i) acc[i] *= f;
                m = sc; }
            const float pe = exp2f(sc - m); lsum += pe;
#pragma unroll
            for (int i = 0; i < QW; ++i) acc[i] += pe * bf2f(VT[((size_t)b * D + h * XHD + part * QW + i) * MEMT + k]);
        }
        const float inv = 1.0f / lsum;
#pragma unroll
        for (int i = 0; i < QW; ++i) OX[(size_t)n * D + h * XHD + part * QW + i] = f2bf(acc[i] * inv);
    }
}

template <int WV> struct WaveOps;
template <> struct WaveOps<1> { static DEV float sum(float v) { return v; } };
#ifndef CPU_TEST
template <> struct WaveOps<64> { static DEV float sum(float v) {
#pragma unroll
    for (int o = 1; o < 64; o <<= 1) v += __shfl_xor(v, o);
    return v; } };
#endif
template <int WV> DEV void ph_ln(const PRef p, const float* g, const float* bta, int mode, int route, const float* wr, int gw, int nw, int lane) {
    constexpr int PER = D / WV / 4;
    float* XF = p.k->out; bf16_t* XB = WSP(bf16_t, O_XB);
    const int* tope_r = WSP(const int, O_TOPE); const float* topw_r = WSP(const float, O_TOPW); const int* pose_r = WSP(const int, O_POSE); const unsigned* cnt = WSP(const unsigned, O_CTL);
    int pstart[NEXP];
    if (mode == 1) { int acc = 0;
#pragma unroll
        for (int e = 0; e < NEXP; ++e) { pstart[e] = acc; acc += (int)((cnt[e] + 255u) >> 8) * 256; } }
    for (int row = gw; row < NTOK; row += nw) {
        f32x4 v[PER]; float s = 0.f;
        float* xr = XF + (size_t)row * D;
#pragma unroll
        for (int j = 0; j < PER; ++j) v[j] = *(const f32x4*)(xr + (j * WV + lane) * 4);
        if (mode == 1) {
            const int e0 = tope_r[row * 2], e1 = tope_r[row * 2 + 1]; const float w0 = topw_r[row * 2], w1 = topw_r[row * 2 + 1];
            int r0 = 0, r1 = 0;
#pragma unroll
            for (int e = 0; e < NEXP; ++e) { if (e == e0) r0 = pstart[e]; if (e == e1) r1 = pstart[e]; }
            r0 += pose_r[row * 2]; r1 += pose_r[row * 2 + 1];
            const bf16_t* y0 = WSP(const bf16_t, O_XG) + (size_t)r0 * D; const bf16_t* y1 = WSP(const bf16_t, O_XG) + (size_t)r1 * D;
#pragma unroll
            for (int j = 0; j < PER; ++j) { const u32x2 a = *(const u32x2*)(y0 + (j * WV + lane) * 4), b2 = *(const u32x2*)(y1 + (j * WV + lane) * 4);
                v[j][0] = DN_ALPHA * v[j][0] + w0 * bf2f((bf16_t)(a.x & 0xffffu)) + w1 * bf2f((bf16_t)(b2.x & 0xffffu));
                v[j][1] = DN_ALPHA * v[j][1] + w0 * bf2f((bf16_t)(a.x >> 16)) + w1 * bf2f((bf16_t)(b2.x >> 16));
                v[j][2] = DN_ALPHA * v[j][2] + w0 * bf2f((bf16_t)(a.y & 0xffffu)) + w1 * bf2f((bf16_t)(b2.y & 0xffffu));
                v[j][3] = DN_ALPHA * v[j][3] + w0 * bf2f((bf16_t)(a.y >> 16)) + w1 * bf2f((bf16_t)(b2.y >> 16)); }
        }
#pragma unroll
        for (int j = 0; j < PER; ++j) s += (v[j][0] + v[j][1]) + (v[j][2] + v[j][3]);
        const float mean = WaveOps<WV>::sum(s) * (1.0f / D); float s2 = 0.f;
#pragma unroll
        for (int j = 0; j < PER; ++j) { v[j] = v[j] - mean; s2 += (v[j][0] * v[j][0] + v[j][1] * v[j][1]) + (v[j][2] * v[j][2] + v[j][3] * v[j][3]); }
        const float rstd = 1.0f / sqrtf(WaveOps<WV>::sum(s2) * (1.0f / D) + LN_EPS);
        float lg[NEXP];
#pragma unroll
        for (int e = 0; e < NEXP; ++e) lg[e] = 0.f;
#pragma unroll
        for (int j = 0; j < PER; ++j) { const int c0 = (j * WV + lane) * 4; const f32x4 gv = *(const f32x4*)(g + c0), bv = *(const f32x4*)(bta + c0);
            f32x4 o = v[j] * rstd * gv + bv; *(f32x4*)(xr + c0) = o; u32x2 w; w.x = pk2(o[0], o[1]); w.y = pk2(o[2], o[3]); *(u32x2*)(XB + (size_t)row * D + c0) = w;
            if (route) {
#pragma unroll
                for (int q = 0; q < 4; ++q) { const f32x4 r0 = *(const f32x4*)(wr + (size_t)(c0 + q) * NEXP), r1 = *(const f32x4*)(wr + (size_t)(c0 + q) * NEXP + 4);
                    lg[0] += o[q] * r0[0]; lg[1] += o[q] * r0[1]; lg[2] += o[q] * r0[2]; lg[3] += o[q] * r0[3]; lg[4] += o[q] * r1[0]; lg[5] += o[q] * r1[1]; lg[6] += o[q] * r1[2]; lg[7] += o[q] * r1[3]; } } }
        if (route) {
#pragma unroll
            for (int e = 0; e < NEXP; ++e) lg[e] = WaveOps<WV>::sum(lg[e]);
            if (lane == 0) {
                int e0 = 0; float m0 = lg[0];
#pragma unroll
                for (int e = 1; e < NEXP; ++e) if (lg[e] > m0) { m0 = lg[e]; e0 = e; }
                int e1 = -1; float m1 = -3e38f;
#pragma unroll
                for (int e = 0; e < NEXP; ++e) if (e != e0 && lg[e] > m1) { m1 = lg[e]; e1 = e; }
                const float w1 = 1.0f / (1.0f + expf(m0 - m1)), w0 = 1.0f - w1;
                int* tope = WSP(int, O_TOPE); float* topw = WSP(float, O_TOPW); int* pose = WSP(int, O_POSE); unsigned* cw = WSP(unsigned, O_CTL);
                tope[row * 2] = e0; tope[row * 2 + 1] = e1; topw[row * 2] = w0; topw[row * 2 + 1] = w1;
#ifndef CPU_TEST
                pose[row * 2] = (int)atomicAdd(cw + e0, 1u); pose[row * 2 + 1] = (int)atomicAdd(cw + e1, 1u);
#else
                pose[row * 2] = (int)cw[e0]++; pose[row * 2 + 1] = (int)cw[e1]++;
#endif
            }
        }
    }
}
DEV void ph_moe_gather(const PRef p, const Ctx& c) {
    const unsigned* cnt = WSP(const unsigned, O_CTL); const int* tope = WSP(const int, O_TOPE); const int* pose = WSP(const int, O_POSE);
    const bf16_t* XB = WSP(const bf16_t, O_XB); bf16_t* XG = WSP(bf16_t, O_XG);
    int pstart[NEXP]; { int acc = 0;
#pragma unroll
        for (int e = 0; e < NEXP; ++e) { pstart[e] = acc; acc += (int)((cnt[e] + 255u) >> 8) * 256; } }
    constexpr int CH = D / 8;
    for (size_t it = c.gtid; it < (size_t)NTOK * 2 * CH; it += c.gsz) {
        const int ch = (int)(it % CH), tk = (int)(it / CH), e = tope[tk];
        int r = 0;
#pragma unroll
        for (int q = 0; q < NEXP; ++q) if (q == e) r = pstart[q];
        r += pose[tk];
        *(u32x4*)(XG + (size_t)r * D + ch * 8) = *(const u32x4*)(XB + (size_t)(tk >> 1) * D + ch * 8);
    }
}
struct Unit { int pm, pn, aux; long aoff, boff; };
struct Gemm { const bf16_t* A; const bf16_t* Bt; int lda, ldb, K; };
constexpr int NXCD = 8, WGM = 8;

struct SchedDense {
    int nM, nN, nwg, G, c, lda, ldb;
    HD void init(int M, int N, int lda_, int ldb_, int G_, int c_) { nM = M / 256; nN = N / 256; nwg = nM * nN; G = G_; c = c_; lda = lda_; ldb = ldb_; }
    HD bool next(int i, Unit& u) const {
        const long L = (long)i * G + c; if (L >= nwg) return false;
        int wgid = (int)L; { const int q = nwg / NXCD, r = nwg % NXCD, xcd = wgid % NXCD, off = wgid / NXCD; wgid = (xcd < r ? xcd * (q + 1) : r * (q + 1) + (xcd - r) * q) + off; }
        const int nig = WGM * nN, gid = wgid / nig, fm = gid * WGM, gsz = (nM - fm) < WGM ? (nM - fm) : WGM;
        u.pm = fm + ((wgid % nig) % gsz); u.pn = (wgid % nig) / gsz; u.aux = u.pm;
        u.aoff = (long)u.pm * 256 * lda * 2; u.boff = (long)u.pn * 256 * ldb * 2; return true;
    }
};
struct SchedKV {
    int G, c;
    HD void init(int G_, int c_) { G = G_; c = c_; }
    HD bool next(int i, Unit& u) const {
        constexpr int nM = NMEM / 256, nN = 2 * D / 256;
        const int L = i * G + c; if (L >= 2 * nM * nN) return false;
        u.aux = L / (nM * nN); u.pm = (L % (nM * nN)) / nN; u.pn = L % nN;
        u.aoff = (long)u.pm * 256 * D * 2; u.boff = ((long)u.aux * 2 * D + u.pn * 256) * D * 2; return true;
    }
};
struct SchedMoe {
    int G, c, t0, t1, nN, which; int tend[NEXP];
    HD void init(const unsigned* cnt, int half, int which_, int G_, int c_) {
        G = G_; c = c_; which = which_; int acc = 0;
        for (int e = 0; e < NEXP; ++e) { acc += (int)((cnt[e] + 255u) >> 8); tend[e] = acc; }
        const int th = (acc + 1) / 2; t0 = half == 0 ? 0 : th; t1 = half == 0 ? th : acc;
        nN = which == 0 ? 2 * FFE / 256 : D / 256;
    }
    HD bool next(int i, Unit& u) const {
        const long L = (long)i * G + c; if (L >= (long)(t1 - t0) * nN) return false;
        const int t = t0 + (int)(L / nN); u.pn = (int)(L % nN); u.pm = t; u.aux = t - t0;
        int e = 0;
        for (int q = 0; q < NEXP - 1; ++q) e += (t >= tend[q]) ? 1 : 0;
        if (which == 0) { u.aoff = (long)t * 256 * D * 2; u.boff = ((long)e * 2 * FFE + u.pn * 256) * D * 2; }
        else { u.aoff = (long)u.aux * 256 * FFE * 2; u.boff = ((long)e * D + u.pn * 256) * FFE * 2; }
        return true;
    }
};

struct EpiStore {
    static constexpr bool PAIR = false; bf16_t* O; int ldc; float scale;
    DEV void apply(const Unit& u, int r, int c, f32x4 v) const { u32x2 w; w.x = pk2(v[0] * scale, v[1] * scale); w.y = pk2(v[2] * scale, v[3] * scale);
        *(u32x2*)(O + (size_t)(u.pm * 256 + r) * ldc + u.pn * 256 + c) = w; }
};
struct EpiResid {
    static constexpr bool PAIR = false; const float* src; float* dst;
    DEV void apply(const Unit& u, int r, int c, f32x4 v) const { const size_t o = (size_t)(u.pm * 256 + r) * D + u.pn * 256 + c; const f32x4 s = *(const f32x4*)(src + o); *(f32x4*)(dst + o) = s * DN_ALPHA + v; }
};
struct EpiKV {
    static constexpr bool PAIR = false; bf16_t* KM; bf16_t* VT;
    DEV void apply(const Unit& u, int r, int c, f32x4 v) const { const int row = u.pm * 256 + r, col = u.pn * 256 + c;
        if (col < D) { u32x2 w; w.x = pk2(v[0], v[1]); w.y = pk2(v[2], v[3]); *(u32x2*)(KM + ((size_t)u.aux * NMEM + row) * D + col) = w; }
        else { const int b = row / MEMT, key = row % MEMT; bf16_t* o = VT + (((size_t)u.aux * NB + b) * D + (col - D)) * MEMT + key;
            o[0] = f2bf(v[0]); o[MEMT] = f2bf(v[1]); o[2 * MEMT] = f2bf(v[2]); o[3 * MEMT] = f2bf(v[3]); } }
};
struct EpiSwiglu {
    static constexpr bool PAIR = true; bf16_t* H; int ldh;
    DEV void apply2(const Unit& u, int r, int c, f32x4 g, f32x4 up) const { u32x2 w; w.x = pk2(siluf_(g[0]) * up[0], siluf_(g[1]) * up[1]); w.y = pk2(siluf_(g[2]) * up[2], siluf_(g[3]) * up[3]);
        *(u32x2*)(H + (size_t)(u.aux * 256 + r) * ldh + u.pn * 128 + c) = w; }
};

#ifdef CPU_TEST
template <class Sched, class Epi> static void gemm_cpu(const Gemm& g, Sched S_, const Epi& E, int G) {
    float* tile = new float[256 * 256];
    for (int c = 0; c < G; ++c) { Sched S2 = S_; S2.c = c; S2.G = G; Unit u;
        for (int i = 0; S2.next(i, u); ++i) {
            const bf16_t* A = (const bf16_t*)((const char*)g.A + u.aoff); const bf16_t* B = (const bf16_t*)((const char*)g.Bt + u.boff);
            for (int r = 0; r < 256; ++r) for (int cc = 0; cc < 256; ++cc) { float a = 0.f; for (int k = 0; k < g.K; ++k) a += bf2f(A[(size_t)r * g.lda + k]) * bf2f(B[(size_t)cc * g.ldb + k]); tile[r * 256 + cc] = a; }
            for (int r = 0; r < 256; ++r) {
                if constexpr (Epi::PAIR) { for (int cc = 0; cc < 128; cc += 4) E.apply2(u, r, cc, *(f32x4*)(tile + r * 256 + cc), *(f32x4*)(tile + r * 256 + 128 + cc)); }
                else { for (int cc = 0; cc < 256; cc += 4) E.apply(u, r, cc, *(f32x4*)(tile + r * 256 + cc)); } } } }
    delete[] tile;
}
#endif
#ifndef CPU_TEST
#define LAS __attribute__((address_space(3)))
typedef short bf16x8 __attribute__((ext_vector_type(8)));
constexpr int BK = 64, HALF = 128, HTB = HALF * BK * 2;
__host__ __device__ __forceinline__ int lds_byte(int r, int c) { const int st = (r >> 4) * 2 + (c >> 5), rr = r & 15, cc = c & 31, ob = rr * 64 + cc * 2; return st * 1024 + (ob ^ (((ob >> 9) & 1) << 5)); }
__host__ __device__ __forceinline__ void stage_rc(int b, int& R, int& C) { const int st = b / 1024, sb = b % 1024, swz = sb ^ (((sb >> 9) & 1) << 5); R = (st >> 1) * 16 + swz / 64; C = (st & 1) * 32 + (swz % 64) / 2; }

template <class Epi> __device__ __forceinline__ void run_epi(const Epi& E, const f32x4 (&acc)[2][2][4][2], const Unit& u, int wr, int wc, int fr, int fq) {
#pragma unroll
    for (int ai = 0; ai < 2; ++ai)
#pragma unroll
        for (int m = 0; m < 4; ++m) { const int r = ai * HALF + wr * 64 + m * 16 + fr;
            if constexpr (Epi::PAIR) {
#pragma unroll
                for (int n = 0; n < 2; ++n) E.apply2(u, r, wc * 32 + n * 16 + 4 * fq, acc[ai][0][m][n], acc[ai][1][m][n]);
                asm volatile("" ::: "memory");
            } else {
#pragma unroll
                for (int bj = 0; bj < 2; ++bj)
#pragma unroll
                    for (int n = 0; n < 2; ++n) E.apply(u, r, bj * HALF + wc * 32 + n * 16 + 4 * fq, acc[ai][bj][m][n]);
                asm volatile("" ::: "memory");
            } }
}

template <class Epi, class Sched>
__device__ __forceinline__ void gemm_phase(LAS unsigned char* lds, const int tid  , const Gemm g, const Sched& S, const Epi& E) {
    const int wid = __builtin_amdgcn_readfirstlane(tid >> 6), lane = tid & 63, wr = wid >> 2, wc = wid & 3, fr = lane & 15, fq = lane >> 4;
    const int K = g.K, nt = K / BK;
    unsigned voffA[2], voffB[2];
#pragma unroll
    for (int i = 0; i < 2; ++i) { int R, C; stage_rc(tid * 16 + i * 8192, R, C); voffA[i] = (unsigned)(R * g.lda + C) * 2u; voffB[i] = (unsigned)(R * g.ldb + C) * 2u; }
    const size_t kstep = (size_t)(BK * 2);
    const size_t hstepA = (size_t)HALF * g.lda * 2, hstepB = (size_t)HALF * g.ldb * 2;
    const unsigned ldsw = (unsigned)wid * 1024u;
    const int aoff = lds_byte(wr * 64 + fr, fq * 8), boff = lds_byte(wc * 32 + fr, fq * 8);
#define PG8_SA(b, h) (((b) * 2 + (h)) * HTB)
#define PG8_SB(b, h) ((4 + (b) * 2 + (h)) * HTB)
#define PG8_STAGE(bufoff, gbase, voff) do { _Pragma("unroll") for (int _i = 0; _i < 2; ++_i) \
        __builtin_amdgcn_global_load_lds((const unsigned*)((const char*)(gbase) + (voff)[_i]), (LAS unsigned*)(lds + (bufoff) + ldsw + _i * 8192), 16, 0, 0); } while (0)
#define PG8_LDA(dst, b, h) do { _Pragma("unroll") for (int m = 0; m < 4; ++m) _Pragma("unroll") for (int k = 0; k < 2; ++k) dst[m][k] = *(const LAS bf16x8*)(lds + PG8_SA(b, h) + aoff + m * 2048 + k * 1024); } while (0)
#define PG8_LDB(dst, b, h) do { _Pragma("unroll") for (int n = 0; n < 2; ++n) _Pragma("unroll") for (int k = 0; k < 2; ++k) dst[n][k] = *(const LAS bf16x8*)(lds + PG8_SB(b, h) + boff + n * 2048 + k * 1024); } while (0)
#define PG8_MMA(ai, bj, At, Bt) do { __builtin_amdgcn_s_setprio(1); _Pragma("unroll") for (int m = 0; m < 4; ++m) _Pragma("unroll") for (int n = 0; n < 2; ++n) _Pragma("unroll") for (int k = 0; k < 2; ++k) \
        acc[ai][bj][m][n] = __builtin_amdgcn_mfma_f32_16x16x32_bf16(Bt[n][k], At[m][k], acc[ai][bj][m][n], 0, 0, 0); __builtin_amdgcn_s_setprio(0); } while (0)
#define PG8_WAIT_V(n) asm volatile("s_waitcnt vmcnt(" #n ")" ::: "memory")
#define PG8_WAIT_L(n) asm volatile("s_waitcnt lgkmcnt(" #n ")" ::: "memory")
#define PG8_BAR __builtin_amdgcn_s_barrier()
#define PG8_SCHED __builtin_amdgcn_sched_barrier(0)
    Unit cur, nxt; int ui = 0;
    if (!S.next(0, cur)) return;
    f32x4 acc[2][2][4][2];
#pragma unroll
    for (int a = 0; a < 2; ++a)
#pragma unroll
        for (int b = 0; b < 2; ++b)
#pragma unroll
            for (int m = 0; m < 4; ++m)
#pragma unroll
                for (int n = 0; n < 2; ++n) acc[a][b][m][n] = (f32x4){0.f, 0.f, 0.f, 0.f};
    bf16x8 At[4][2], B0[2][2], B1[2][2];
    const char* cA = (const char*)g.A + cur.aoff; const char* cB = (const char*)g.Bt + cur.boff;
    PG8_STAGE(PG8_SB(0, 0), cB, voffB); PG8_STAGE(PG8_SB(0, 1), cB + hstepB, voffB); PG8_STAGE(PG8_SA(0, 0), cA, voffA); PG8_STAGE(PG8_SA(0, 1), cA + hstepA, voffA);
    if (wr == 1) PG8_BAR;
    PG8_WAIT_V(2); PG8_BAR;
    PG8_STAGE(PG8_SB(1, 0), cB + kstep, voffB); PG8_STAGE(PG8_SA(1, 0), cA + kstep, voffA); PG8_STAGE(PG8_SB(1, 1), cB + hstepB + kstep, voffB);
    PG8_WAIT_V(6); PG8_BAR;
    for (;;) {
        const bool has_next = S.next(ui + 1, nxt);
        const char* nA = has_next ? (const char*)g.A + nxt.aoff : cA; const char* nB = has_next ? (const char*)g.Bt + nxt.boff : cB;
        for (int t = 0; t < nt; t += 2) {
            const bool last = (t == nt - 2);
            const char* a1 = cA + (size_t)(t + 1) * kstep;
            const char* a2 = last ? nA : cA + (size_t)(t + 2) * kstep; const char* b2 = last ? nB : cB + (size_t)(t + 2) * kstep;
            const char* a3 = a2 + kstep; const char* b3 = b2 + kstep;
            PG8_LDB(B0, 0, 0); PG8_LDB(B1, 0, 1); PG8_SCHED; PG8_LDA(At, 0, 0); PG8_STAGE(PG8_SA(1, 1), a1 + hstepA, voffA);
            PG8_WAIT_V(8); PG8_WAIT_L(0); PG8_BAR; PG8_MMA(0, 0, At, B0); PG8_MMA(0, 1, At, B1); PG8_BAR; PG8_SCHED;
            PG8_LDA(At, 0, 1); PG8_STAGE(PG8_SB(0, 0), b2, voffB); PG8_STAGE(PG8_SB(0, 1), b2 + hstepB, voffB); PG8_STAGE(PG8_SA(0, 0), a2, voffA);
            PG8_WAIT_V(8); PG8_WAIT_L(0); PG8_BAR; PG8_MMA(1, 0, At, B0); PG8_MMA(1, 1, At, B1); PG8_BAR; PG8_SCHED;
            PG8_LDB(B0, 1, 0); PG8_LDB(B1, 1, 1); PG8_SCHED; PG8_LDA(At, 1, 0); PG8_STAGE(PG8_SA(0, 1), a2 + hstepA, voffA);
            PG8_WAIT_V(8); PG8_WAIT_L(0); PG8_BAR; PG8_MMA(0, 0, At, B0); PG8_MMA(0, 1, At, B1); PG8_BAR; PG8_SCHED;
            PG8_LDA(At, 1, 1); PG8_STAGE(PG8_SB(1, 0), b3, voffB); PG8_STAGE(PG8_SB(1, 1), b3 + hstepB, voffB); PG8_STAGE(PG8_SA(1, 0), a3, voffA);
            PG8_WAIT_V(8); PG8_WAIT_L(0); PG8_BAR; PG8_MMA(1, 0, At, B0); PG8_MMA(1, 1, At, B1); PG8_BAR; PG8_SCHED;
        }
        if (wr == 0) PG8_BAR;
        run_epi(E, acc, cur, wr, wc, fr, fq);
        if (!has_next) break;
#pragma unroll
        for (int a = 0; a < 2; ++a)
#pragma unroll
            for (int b = 0; b < 2; ++b)
#pragma unroll
                for (int m = 0; m < 4; ++m)
#pragma unroll
                    for (int n = 0; n < 2; ++n) acc[a][b][m][n] = (f32x4){0.f, 0.f, 0.f, 0.f};
        cur = nxt; cA = nA; cB = nB; ++ui;
        if (wr == 1) PG8_BAR;
    }
    PG8_WAIT_V(0);
    PG8_BAR;
#undef PG8_SA
#undef PG8_SB
#undef PG8_STAGE
#undef PG8_LDA
#undef PG8_LDB
#undef PG8_MMA
#undef PG8_WAIT_V
#undef PG8_WAIT_L
#undef PG8_BAR
#undef PG8_SCHED
}
#endif
constexpr int STEPS_PER_LAYER = 16, N_STEPS = 2 + 2 * STEPS_PER_LAYER;
struct Exec {
    Ctx c; int G, blk, gw, nw, lane, tid;
#ifndef CPU_TEST
    LAS unsigned char* lds;
#endif
};
#ifdef CPU_TEST
#define RUN_GEMM(g, S, E) gemm_cpu(g, S, E, X.G)
constexpr int WVW = 1;
#else
#define RUN_GEMM(g, S, E) gemm_phase(X.lds, X.tid, g, S, E)
constexpr int WVW = 64;
#endif
constexpr HD bool step_is_empty(int step) { if (step < 2) return false; const int l = (step - 2) / STEPS_PER_LAYER, s = (step - 2) % STEPS_PER_LAYER; return (l % 2 == 0) && (s >= 12 && s <= 14); }

#ifdef STEP_SET
#define EN(k) (((STEP_SET) >> (k)) & 1)
#else
#define EN(k) 1
#endif
HD int rot_id(int gtid, int gsz, int off) { long v = (long)gsz - 1 - gtid - (off % gsz); if (v < 0) v += gsz; return (int)v; }
DEV void run_step(const PRef p, int step, const Exec& X) {
    const Ctx& c = X.c;
    if (step == 0) { if (EN(16)) ph_prologue(p, c); return; }
    if (step == 1) { if (!EN(17)) return; Gemm g{WSP(const bf16_t, O_MEMB), WSP(const bf16_t, O_XKV_T), D, D, D}; SchedKV S; S.init(X.G, X.blk); EpiKV E{WSP(bf16_t, O_KMEM), WSP(bf16_t, O_VT)}; RUN_GEMM(g, S, E); return; }
    const int l = (step - 2) / STEPS_PER_LAYER, s = (step - 2) % STEPS_PER_LAYER; const bool moe = (l % 2) == 1;
    switch (s) {
    case 0: if (EN(0)) { Gemm g{WSP(const bf16_t, O_XB), WSP(const bf16_t, O_WIN_T) + (size_t)l * DINP * D, D, D, D}; SchedDense S; S.init(NTOK, DINP, D, D, X.G, X.blk);
        EpiStore E{WSP(bf16_t, O_PROJ), DINP, 1.0f}; RUN_GEMM(g, S, E); } break;
    case 1: if (EN(1)) ph_prep(p, l, c); break;
    case 2: if (EN(2)) { ph_attn_naive(p, c);
        Ctx c2{rot_id(c.gtid, c.gsz, 0), c.gsz}; ph_gdn_naive(p, c2);
        Ctx c3{rot_id(c.gtid, c.gsz, 4096), c.gsz}; ph_hgrn_naive(p, c3); } break;
    case 3: if (EN(3)) ph_combine(p, l, c); break;
    case 4: if (EN(4)) { Gemm g{WSP(const bf16_t, O_MIXED), WSP(const bf16_t, O_WOUT_T) + (size_t)l * D * MIXW, MIXW, MIXW, MIXW}; SchedDense S; S.init(NTOK, D, MIXW, MIXW, X.G, X.blk);
        EpiResid E{l == 0 ? p.k->in[I_X] : p.k->out, p.k->out}; RUN_GEMM(g, S, E); } break;
    case 5: if (EN(5)) ph_ln<WVW>(p, p.k->in[I_LN1G] + l * D, p.k->in[I_LN1B] + l * D, 0, 0, nullptr, X.gw, X.nw, X.lane); break;
    case 6: if (EN(6)) { Gemm g{WSP(const bf16_t, O_XB), WSP(const bf16_t, O_XQ_T) + (size_t)l * D * D, D, D, D}; SchedDense S; S.init(NTOK, D, D, D, X.G, X.blk);
        EpiStore E{WSP(bf16_t, O_QX), D, LOG2E / sqrtf((float)XHD)}; RUN_GEMM(g, S, E); } break;
    case 7: if (EN(7)) ph_xattn_naive(p, l, c); break;
    case 8: if (EN(8)) { Gemm g{WSP(const bf16_t, O_MIXED), WSP(const bf16_t, O_XO_T) + (size_t)l * D * D, D, D, D}; SchedDense S; S.init(NTOK, D, D, D, X.G, X.blk);
        EpiResid E{p.k->out, p.k->out}; RUN_GEMM(g, S, E); } break;
    case 9: if (EN(9)) ph_ln<WVW>(p, p.k->in[I_LN2G] + l * D, p.k->in[I_LN2B] + l * D, 0, moe ? 1 : 0, p.k->in[I_ROUTER] + (size_t)(l / 2) * D * NEXP, X.gw, X.nw, X.lane); break;
    case 10: if (!EN(10)) break; if (!moe) { Gemm g{WSP(const bf16_t, O_XB), WSP(const bf16_t, O_FGU_T), D, D, D}; SchedDense S; S.init(NTOK, 2 * FF, D, D, X.G, X.blk); EpiSwiglu E{WSP(bf16_t, O_HID), FF}; RUN_GEMM(g, S, E); }
             else { ph_moe_weights(p, c); ph_moe_gather(p, c); } break;
    case 11: case 13:
        if (!EN(11)) break; if (!moe) { if (s == 11) { Gemm g{WSP(const bf16_t, O_HID), WSP(const bf16_t, O_FD_T), FF, FF, FF}; SchedDense S; S.init(NTOK, D, FF, FF, X.G, X.blk); EpiResid E{p.k->out, p.k->out}; RUN_GEMM(g, S, E); } }
        else { Gemm g{WSP(const bf16_t, O_XG), WSP(const bf16_t, O_MGU_T), D, D, D}; SchedMoe S; S.init(WSP(const unsigned, O_CTL), s == 11 ? 0 : 1, 0, X.G, X.blk);
               EpiSwiglu E{WSP(bf16_t, O_HIDM), FFE}; RUN_GEMM(g, S, E); } break;
    case 12: case 14: if (EN(12) && moe) { Gemm g{WSP(const bf16_t, O_HIDM), WSP(const bf16_t, O_MD_T), FFE, FFE, FFE}; SchedMoe S; S.init(WSP(const unsigned, O_CTL), s == 12 ? 0 : 1, 1, X.G, X.blk);
                 EpiStore E{WSP(bf16_t, O_XG), D, 1.0f}; RUN_GEMM(g, S, E); } break;
    case 15: if (EN(15)) ph_ln<WVW>(p, p.k->in[I_LN3G] + l * D, p.k->in[I_LN3B] + l * D, moe ? 1 : 0, 0, nullptr, X.gw, X.nw, X.lane); break;
    default: break;
    }
}

#ifndef CPU_TEST
namespace cg = cooperative_groups;
constexpr int LDS_BYTES = 147456;
__device__ __forceinline__ void run_step_fresh(int step) {
    KargPtr kp = (KargPtr)__builtin_amdgcn_kernarg_segment_ptr(); asm volatile("" : "+s"(kp));
    const PRef p{kp};
    extern __shared__ __attribute__((aligned(16))) unsigned char lds_raw[];
    int tid = threadIdx.x, blk = blockIdx.x, G = gridDim.x; asm volatile("" : "+v"(tid)); asm volatile("" : "+s"(blk)); asm volatile("" : "+s"(G));
    Exec X; const int wave = __builtin_amdgcn_readfirstlane(tid >> 6);
    X.G = G; X.blk = blk; X.tid = tid; X.lane = tid & 63; X.gw = wave * X.G + X.blk; X.nw = X.G * 8; X.c.gtid = X.gw * 64 + X.lane; X.c.gsz = X.nw * 64;
    X.lds = (LAS unsigned char*)lds_raw;
    run_step(p, step, X);
}
template <int STEP> __device__ __forceinline__ void prog(int lo, int hi, cg::grid_group& grid) {
    if constexpr (STEP < N_STEPS) {
        if constexpr (!step_is_empty(STEP)) { if (STEP >= lo && STEP < hi) { run_step_fresh(STEP); if (STEP + 1 < hi) grid.sync(); } }
        prog<STEP + 1>(lo, hi, grid);
    }
}
__global__ void __launch_bounds__(512, 2) mega(Params p) {
    cg::grid_group grid = cg::this_grid();
#ifdef ONLY_STEP
    run_step_fresh(ONLY_STEP); if (p.hi > 100) grid.sync();
#else
    prog<0>(p.lo, p.hi, grid);
#endif
}

extern "C" void kernel_launch(void* const* d_in, const int* in_sizes, int n_in, void* d_out, int out_size, void* d_ws, size_t ws_size, hipStream_t stream) {
    static int grid = 0;
    if (grid == 0) {
        if (n_in != N_IN || out_size != NTOK * D || ws_size < WS_TOTAL) { fprintf(stderr, "kernel_launch: unexpected problem (n_in %d, out %d, ws %zu < %zu)\n", n_in, out_size, ws_size, (size_t)WS_TOTAL); grid = -1; return; }
        int dev = 0, cus = 0, per_cu = 0;
        hipGetDevice(&dev); hipDeviceGetAttribute(&cus, hipDeviceAttributeMultiprocessorCount, dev);
        hipFuncSetAttribute((const void*)mega, hipFuncAttributeMaxDynamicSharedMemorySize, LDS_BYTES);
        hipOccupancyMaxActiveBlocksPerMultiprocessor(&per_cu, (const void*)mega, 512, LDS_BYTES);
        if (per_cu < 1) { fprintf(stderr, "kernel_launch: occupancy query says %d blocks per CU\n", per_cu); grid = -1; return; }
        grid = cus;
    }
    if (grid < 0) return;
    Params p{};
    for (int i = 0; i < N_IN; ++i) p.in[i] = (const float*)d_in[i];
    p.out = (float*)d_out; p.ws = (unsigned char*)d_ws;
#if defined(MULTI_LAUNCH)
    for (int s = 0; s < N_STEPS; ++s) { if (step_is_empty(s)) continue; p.lo = s; p.hi = s + 1; hipLaunchKernelGGL(mega, dim3(grid), dim3(512), LDS_BYTES, stream, p); }
#else
    p.lo = 0; p.hi = N_STEPS;
    void* args[] = {&p};
    hipError_t e = hipLaunchCooperativeKernel((const void*)mega, dim3(grid), dim3(512), args, LDS_BYTES, stream);
    if (e != hipSuccess) fprintf(stderr, "cooperative launch failed: %s (grid %d)\n", hipGetErrorString(e), grid);
#endif
}
#endif
```

```cpp
#ifndef CPU_TEST
#include <hip/hip_runtime.h>
#include <hip/hip_cooperative_groups.h>
#include <hip/hip_bf16.h>
#include <cstdio>
#include <cstdint>
#define DEV __device__ __forceinline__
#define HD __host__ __device__ __forceinline__
#else
#include <cstdio>
#include <cstdint>
#include <cstring>
#include <cmath>
#define DEV inline
#define HD inline
#endif

#ifndef CFG_D
#define CFG_D 1024
#define CFG_B 4
#define CFG_S 4096
#define CFG_MEM 256
#define CFG_FF 2816
#define CFG_FFE 3584
#endif
constexpr int D = CFG_D, NB = CFG_B, S = CFG_S, NTOK = NB * S, MEMT = CFG_MEM, FF = CFG_FF, FFE = CFG_FFE;
constexpr int XH = 4, XHD = D / XH, NMEM = NB * MEMT;
constexpr int DIN = 3480, DINP = 3584, MIXW = 1024;
constexpr int NEXP = 8;
constexpr int MOE_TMAX = 2 * NTOK / 256 + NEXP, MOE_THALF = (MOE_TMAX + 1) / 2, MOE_ROWS = MOE_TMAX * 256;
constexpr int C_AQKV = 0, C_AZ = 1152, C_ABETA = 1536, C_ADECAY = 1548, C_BQ = 1560, C_BK = 1944, C_BV = 2072, C_CF = 2200, C_CI = 2712, C_CQ = 2968, C_CG = 3224;
constexpr float DN_ALPHA = 1.41421356237309515f;
constexpr float LN_EPS = 1e-5f, RMS_EPS = 1e-6f;
constexpr float LOG2E = 1.4426950408889634f;

typedef unsigned short bf16_t;
typedef float f32x4 __attribute__((ext_vector_type(4)));
typedef unsigned u32x4 __attribute__((ext_vector_type(4)));
typedef unsigned u32x2 __attribute__((ext_vector_type(2)));

DEV float bf2f(bf16_t h) { unsigned u = (unsigned)h << 16; float f; __builtin_memcpy(&f, &u, 4); return f; }
DEV bf16_t f2bf(float f) { unsigned u; __builtin_memcpy(&u, &f, 4); return (bf16_t)((u + 0x7fffu + ((u >> 16) & 1u)) >> 16); }
DEV unsigned pk2(float lo, float hi) { return (unsigned)f2bf(lo) | ((unsigned)f2bf(hi) << 16); }
DEV float sigmoidf_(float x) { return 1.0f / (1.0f + expf(-x)); }
DEV float siluf_(float x) { return x / (1.0f + expf(-x)); }
DEV float softplusf_(float x) { return x > 20.f ? x : log1pf(expf(x)); }

enum { I_X = 0, I_MEM, I_WIN, I_CONVW, I_ALOG, I_DTB, I_GDNNW, I_QNW, I_KNW, I_LBL, I_HGNW, I_WOUT, I_LN1G, I_LN1B, I_XQ, I_XK, I_XV, I_XO,
       I_LN2G, I_LN2B, I_FWG, I_FWU, I_FWD, I_ROUTER, I_MWG, I_MWU, I_MWD, I_LN3G, I_LN3B, N_IN };
struct Params { const float* in[N_IN]; float* out; unsigned char* ws; int lo, hi; };
#ifdef CPU_TEST
typedef const Params* KargPtr;
#else
typedef const __attribute__((address_space(4))) Params* KargPtr;
#endif
struct PRef { KargPtr k; };

constexpr size_t al256(size_t x) { return (x + 255) & ~(size_t)255; }
constexpr size_t O_CTL = 0;
constexpr size_t O_LB = 4096;
constexpr size_t O_ROPE = O_LB + 2 * 256 * 4;
constexpr size_t O_TOPE = al256(O_ROPE + 64 * 16 * 2 * 4);
constexpr size_t O_TOPW = O_TOPE + (size_t)NTOK * 8;
constexpr size_t O_POSE = O_TOPW + (size_t)NTOK * 8;
constexpr size_t O_WIN_T = al256(O_POSE + (size_t)NTOK * 8);
constexpr size_t O_WOUT_T = O_WIN_T + (size_t)2 * DINP * D * 2;
constexpr size_t O_XQ_T = O_WOUT_T + (size_t)2 * D * MIXW * 2;
constexpr size_t O_XO_T = O_XQ_T + (size_t)2 * D * D * 2;
constexpr size_t O_XKV_T = O_XO_T + (size_t)2 * D * D * 2;
constexpr size_t O_FGU_T = O_XKV_T + (size_t)2 * 2 * D * D * 2;
constexpr size_t O_FD_T = O_FGU_T + (size_t)2 * FF * D * 2;
constexpr size_t O_MEMB = O_FD_T + (size_t)D * FF * 2;
constexpr size_t O_KMEM = O_MEMB + (size_t)NMEM * D * 2;
constexpr size_t O_VT = O_KMEM + (size_t)2 * NMEM * D * 2;
constexpr size_t O_XB = O_VT + (size_t)2 * NMEM * D * 2;
constexpr size_t O_R0 = al256(O_XB + (size_t)NTOK * D * 2);
constexpr size_t O_PROJ = O_R0;
constexpr size_t O_AQ = O_PROJ + (size_t)NTOK * DINP * 2;
constexpr size_t O_AK = O_AQ + (size_t)NTOK * 384 * 2;
constexpr size_t O_AV = O_AK + (size_t)NTOK * 384 * 2;
constexpr size_t O_QB = O_AV + (size_t)NTOK * 384 * 2;
constexpr size_t O_KB = O_QB + (size_t)NTOK * 384 * 2;
constexpr size_t O_KIN = O_KB + (size_t)NTOK * 128 * 2;
constexpr size_t O_CQ = O_KIN + (size_t)2 * NTOK * 256 * 2;
constexpr size_t O_OA = O_CQ + (size_t)NTOK * 256 * 2;
constexpr size_t O_OC = O_OA + (size_t)2 * NTOK * 384 * 4;
constexpr size_t O_MIXED = O_OC + (size_t)2 * NTOK * 256 * 4;
constexpr size_t O_BETA = O_MIXED + (size_t)NTOK * 1024 * 2;
constexpr size_t O_GG = O_BETA + (size_t)2 * NTOK * 6 * 4;
constexpr size_t O_QX = al256(O_GG + (size_t)2 * NTOK * 6 * 4);
constexpr size_t O_MIX_END = O_QX + (size_t)NTOK * D * 2;
constexpr size_t O_HID = O_R0;
constexpr size_t O_MGU_T = O_R0;
constexpr size_t O_MD_T = O_MGU_T + (size_t)NEXP * 2 * FFE * D * 2;
constexpr size_t O_XG = O_MD_T + (size_t)NEXP * D * FFE * 2;
constexpr size_t O_HIDM = O_XG + (size_t)MOE_ROWS * D * 2;
constexpr size_t O_MOE_END = O_HIDM + (size_t)MOE_THALF * 256 * FFE * 2;
constexpr size_t WS_TOTAL = O_MIX_END > O_MOE_END ? O_MIX_END : O_MOE_END;
static_assert(O_HID + (size_t)NTOK * FF * 2 <= WS_TOTAL, "ws map");
struct Ctx { int gtid, gsz; };
#ifdef CPU_TEST
#define FENCE() do {} while (0)
#else
#define FENCE() asm volatile("" ::: "memory")
#endif
#define WSP(T, off) ((T*)(p.k->ws + (off)))

DEV void cvt_wt(const Ctx& c, const float* W, int K, int N, bf16_t* WT, int mode, int row_off) {
    const size_t items = (size_t)(K / 8) * N;
    for (size_t it = c.gtid; it < items; it += c.gsz) {
        const int n = (int)(it % N), k0 = (int)(it / N) * 8;
        const int row = mode == 0 ? row_off + n : (n >> 7) * 256 + (mode == 2 ? 128 : 0) + (n & 127);
        u32x4 o;
        o.x = pk2(W[(size_t)(k0 + 0) * N + n], W[(size_t)(k0 + 1) * N + n]); o.y = pk2(W[(size_t)(k0 + 2) * N + n], W[(size_t)(k0 + 3) * N + n]);
        o.z = pk2(W[(size_t)(k0 + 4) * N + n], W[(size_t)(k0 + 5) * N + n]); o.w = pk2(W[(size_t)(k0 + 6) * N + n], W[(size_t)(k0 + 7) * N + n]);
        *(u32x4*)(WT + (size_t)row * K + k0) = o;
    }
}
DEV void cvt_rows(const Ctx& c, const float* X, bf16_t* Y, size_t n) {
    for (size_t i = c.gtid; i < n / 4; i += c.gsz) { const f32x4 v = *(const f32x4*)(X + 4 * i); u32x2 o; o.x = pk2(v[0], v[1]); o.y = pk2(v[2], v[3]); *(u32x2*)(Y + 4 * i) = o; }
}
DEV void ph_prologue(const PRef p, const Ctx& c) {
    unsigned* ctl = WSP(unsigned, O_CTL);
    for (int i = c.gtid; i < 1024; i += c.gsz) ctl[i] = 0u;
    float* lb = WSP(float, O_LB);
    for (int i = c.gtid; i < 256; i += c.gsz) { const float l0 = p.k->in[I_LBL][i], l1 = p.k->in[I_LBL][256 + i]; lb[i] = 0.f; lb[256 + i] = 1.0f / (1.0f + expf(l0 - l1)); }
    float* rope = WSP(float, O_ROPE);
    for (int i = c.gtid; i < 64 * 16; i += c.gsz) { const int pos = i >> 4, f = i & 15; const float inv = exp2f(-(float)f * (13.287712379549449f / 16.0f)), a = (float)pos * inv;
        rope[2 * i] = cosf(a); rope[2 * i + 1] = sinf(a); }
    cvt_rows(c, p.k->in[I_X], WSP(bf16_t, O_XB), (size_t)NTOK * D);
    cvt_rows(c, p.k->in[I_MEM], WSP(bf16_t, O_MEMB), (size_t)NMEM * D);
    for (int l = 0; l < 2; ++l) {
        bf16_t* wi = WSP(bf16_t, O_WIN_T) + (size_t)l * DINP * D;
        cvt_wt(c, p.k->in[I_WIN] + (size_t)l * D * DIN, D, DIN, wi, 0, 0);
        for (size_t i = c.gtid; i < (size_t)(DINP - DIN) * D / 8; i += c.gsz) *(u32x4*)(wi + (size_t)DIN * D + 8 * i) = (u32x4){0u, 0u, 0u, 0u};
        cvt_wt(c, p.k->in[I_WOUT] + (size_t)l * MIXW * D, MIXW, D, WSP(bf16_t, O_WOUT_T) + (size_t)l * D * MIXW, 0, 0);
        cvt_wt(c, p.k->in[I_XQ] + (size_t)l * D * D, D, D, WSP(bf16_t, O_XQ_T) + (size_t)l * D * D, 0, 0);
        cvt_wt(c, p.k->in[I_XO] + (size_t)l * D * D, D, D, WSP(bf16_t, O_XO_T) + (size_t)l * D * D, 0, 0);
        cvt_wt(c, p.k->in[I_XK] + (size_t)l * D * D, D, D, WSP(bf16_t, O_XKV_T) + (size_t)l * 2 * D * D, 0, 0);
        cvt_wt(c, p.k->in[I_XV] + (size_t)l * D * D, D, D, WSP(bf16_t, O_XKV_T) + (size_t)l * 2 * D * D, 0, D);
    }
    cvt_wt(c, p.k->in[I_FWG], D, FF, WSP(bf16_t, O_FGU_T), 1, 0);
    cvt_wt(c, p.k->in[I_FWU], D, FF, WSP(bf16_t, O_FGU_T), 2, 0);
    cvt_wt(c, p.k->in[I_FWD], FF, D, WSP(bf16_t, O_FD_T), 0, 0);
}
DEV void ph_moe_weights(const PRef p, const Ctx& c) {
    for (int e = 0; e < NEXP; ++e) {
        cvt_wt(c, p.k->in[I_MWG] + (size_t)e * D * FFE, D, FFE, WSP(bf16_t, O_MGU_T) + (size_t)e * 2 * FFE * D, 1, 0);
        cvt_wt(c, p.k->in[I_MWU] + (size_t)e * D * FFE, D, FFE, WSP(bf16_t, O_MGU_T) + (size_t)e * 2 * FFE * D, 2, 0);
        cvt_wt(c, p.k->in[I_MWD] + (size_t)e * FFE * D, FFE, D, WSP(bf16_t, O_MD_T) + (size_t)e * D * FFE, 0, 0);
    }
}

DEV void conv8(const bf16_t* proj, const float* cw, int n, int t, int ch, float (&v)[8]) {
#pragma unroll
    for (int i = 0; i < 8; ++i) v[i] = 0.f;
#pragma unroll
    for (int j = 0; j < 5; ++j) { const int tt = t + j - 2;
        if (tt >= 0 && tt < S) { const u32x4 q = *(const u32x4*)(proj + (size_t)(n + j - 2) * DINP + C_AQKV + ch); const f32x4 w0 = *(const f32x4*)(cw + j * 1152 + ch), w1 = *(const f32x4*)(cw + j * 1152 + ch + 4);
            v[0] += bf2f((bf16_t)(q[0] & 0xffffu)) * w0[0]; v[1] += bf2f((bf16_t)(q[0] >> 16)) * w0[1]; v[2] += bf2f((bf16_t)(q[1] & 0xffffu)) * w0[2]; v[3] += bf2f((bf16_t)(q[1] >> 16)) * w0[3];
            v[4] += bf2f((bf16_t)(q[2] & 0xffffu)) * w1[0]; v[5] += bf2f((bf16_t)(q[2] >> 16)) * w1[1]; v[6] += bf2f((bf16_t)(q[3] & 0xffffu)) * w1[2]; v[7] += bf2f((bf16_t)(q[3] >> 16)) * w1[3]; } }
#pragma unroll
    for (int i = 0; i < 8; ++i) v[i] = siluf_(v[i]);
}
DEV void ph_prep(const PRef p, int l, const Ctx& c) {
    const bf16_t* proj = WSP(const bf16_t, O_PROJ);
#ifndef NO_PREP_A
    {
        const float* cw = p.k->in[I_CONVW] + (size_t)l * 5 * 1152;
        for (int it = c.gtid; it < NTOK * 18; it += c.gsz) {
            const int n = it / 18, r = it % 18, h = r % 6, part = r / 6, t = n % S, ch0 = part * 384 + h * 64;
            float sc = 1.f;
            if (part < 2) { float ss = 0.f;
                for (int i = 0; i < 64; i += 8) { float v[8]; conv8(proj, cw, n, t, ch0 + i, v);
#pragma unroll
                    for (int e = 0; e < 8; ++e) ss += v[e] * v[e]; }
                sc = 1.0f / sqrtf(ss + RMS_EPS); if (part == 0) sc *= 0.125f; }
            bf16_t* dst = (part == 0 ? WSP(bf16_t, O_AQ) : part == 1 ? WSP(bf16_t, O_AK) : WSP(bf16_t, O_AV)) + (size_t)n * 384 + h * 64;
            for (int i = 0; i < 64; i += 8) { float v[8]; conv8(proj, cw, n, t, ch0 + i, v);
                u32x4 o; o.x = pk2(v[0] * sc, v[1] * sc); o.y = pk2(v[2] * sc, v[3] * sc); o.z = pk2(v[4] * sc, v[5] * sc); o.w = pk2(v[6] * sc, v[7] * sc); *(u32x4*)(dst + i) = o; }
        }
        float* beta = WSP(float, O_BETA); float* gg = WSP(float, O_GG);
        for (int it = c.gtid; it < 2 * NTOK * 6; it += c.gsz) {
            const int dir = it / (NTOK * 6), r = it % (NTOK * 6), n = r / 6, h = r % 6;
            const float xb_ = bf2f(proj[(size_t)n * DINP + C_ABETA + dir * 6 + h]), xd = bf2f(proj[(size_t)n * DINP + C_ADECAY + dir * 6 + h]);
            beta[it] = sigmoidf_(xb_);
            gg[it] = -expf(p.k->in[I_ALOG][l * 12 + dir * 6 + h]) * softplusf_(xd + p.k->in[I_DTB][l * 12 + dir * 6 + h]);
        }
    }
#endif
#ifndef NO_PREP_B
    {
        const float* rope = WSP(const float, O_ROPE);
        for (int it = c.gtid; it < NTOK * 8; it += c.gsz) {
            const int n = it >> 3, j = it & 7, t = n % S;
            const bf16_t* src = proj + (size_t)n * DINP + (j < 6 ? C_BQ + j * 64 : C_BK + (j - 6) * 64);
            const float* nw = (j < 6 ? p.k->in[I_QNW] : p.k->in[I_KNW]) + l * 64;
            float ss = 0.f;
#pragma unroll
            for (int i = 0; i < 64; i += 8) { const u32x4 q = *(const u32x4*)(src + i);
#pragma unroll
                for (int e = 0; e < 4; ++e) { const float x0 = bf2f((bf16_t)(q[e] & 0xffffu)), x1 = bf2f((bf16_t)(q[e] >> 16)); ss += x0 * x0 + x1 * x1; } }
            const float rs = 1.0f / sqrtf(ss * (1.0f / 64.0f) + RMS_EPS) * ((j < 6) ? 0.125f * LOG2E : 1.0f);
            bf16_t* dst = j < 6 ? WSP(bf16_t, O_QB) + (size_t)n * 384 + j * 64 : WSP(bf16_t, O_KB) + (size_t)n * 128 + (j - 6) * 64;
            for (int a = 0; a < 2; ++a) { const int pos = a == 0 ? t / 64 : t % 64; float v[32];
#pragma unroll
                for (int i = 0; i < 32; i += 8) { const u32x4 q = *(const u32x4*)(src + a * 32 + i); const f32x4 w0 = *(const f32x4*)(nw + a * 32 + i), w1 = *(const f32x4*)(nw + a * 32 + i + 4);
                    v[i] = bf2f((bf16_t)(q[0] & 0xffffu)) * w0[0]; v[i + 1] = bf2f((bf16_t)(q[0] >> 16)) * w0[1]; v[i + 2] = bf2f((bf16_t)(q[1] & 0xffffu)) * w0[2]; v[i + 3] = bf2f((bf16_t)(q[1] >> 16)) * w0[3];
                    v[i + 4] = bf2f((bf16_t)(q[2] & 0xffffu)) * w1[0]; v[i + 5] = bf2f((bf16_t)(q[2] >> 16)) * w1[1]; v[i + 6] = bf2f((bf16_t)(q[3] & 0xffffu)) * w1[2]; v[i + 7] = bf2f((bf16_t)(q[3] >> 16)) * w1[3]; }
#pragma unroll
                for (int i = 0; i < 16; ++i) { const float cs = rope[(pos * 16 + i) * 2] * rs, sn = rope[(pos * 16 + i) * 2 + 1] * rs; const float x1 = v[i], x2 = v[16 + i];
                    v[i] = x1 * cs - x2 * sn; v[16 + i] = x2 * cs + x1 * sn; }
#pragma unroll
                for (int i = 0; i < 32; i += 8) { u32x4 w; w.x = pk2(v[i], v[i + 1]); w.y = pk2(v[i + 2], v[i + 3]); w.z = pk2(v[i + 4], v[i + 5]); w.w = pk2(v[i + 6], v[i + 7]); *(u32x4*)(dst + a * 32 + i) = w; } }
        }
    }
#endif
#ifndef NO_PREP_C
    {
        const float* lb = WSP(const float, O_LB) + l * 256; bf16_t* kin = WSP(bf16_t, O_KIN); bf16_t* cq = WSP(bf16_t, O_CQ);
        for (int it = c.gtid; it < NTOK * 256; it += c.gsz) {
            const int n = it >> 8, ch = it & 255; const bf16_t* row = proj + (size_t)n * DINP;
            const float om = 1.0f - lb[ch];
            kin[(size_t)n * 256 + ch] = f2bf(om * sigmoidf_(-bf2f(row[C_CF + ch])));
            kin[(size_t)(NTOK + n) * 256 + ch] = f2bf(om * sigmoidf_(-bf2f(row[C_CF + 256 + ch])));
            cq[it] = f2bf(siluf_(bf2f(row[C_CQ + ch])) * 0.125f);
        }
    }
#endif
}

DEV void ph_attn_naive(const PRef p, const Ctx& c) {
    const bf16_t* Q = WSP(const bf16_t, O_QB); const bf16_t* Kb = WSP(const bf16_t, O_KB); const bf16_t* proj = WSP(const bf16_t, O_PROJ); bf16_t* mixed = WSP(bf16_t, O_MIXED);
    for (int it = c.gtid; it < NB * 6 * S; it += c.gsz) {
        const int t = it % S, hq = (it / S) % 6, b = it / (6 * S), kv = hq / 3, n = b * S + t;
        float q[64], acc[64];
#pragma unroll
        for (int i = 0; i < 64; ++i) { q[i] = bf2f(Q[(size_t)n * 384 + hq * 64 + i]); acc[i] = 0.f; }
        float m = -1e30f, lsum = 0.f;
        for (int s2 = 0; s2 < S; ++s2) {
            const bf16_t* kr = Kb + (size_t)(b * S + s2) * 128 + kv * 64; const bf16_t* vr = proj + (size_t)(b * S + s2) * DINP + C_BV + kv * 64;
            float sc = 0.f;
#pragma unroll
            for (int i = 0; i < 64; ++i) sc += q[i] * bf2f(kr[i]);
            FENCE();
            if (sc > m) { const float f = exp2f(m - sc); lsum *= f;
#pragma unroll
                for (int i = 0; i < 64; ++i) acc[i] *= f;
                m = sc; }
            const float pe = exp2f(sc - m); lsum += pe;
#pragma unroll
            for (int i = 0; i < 64; ++i) acc[i] += pe * bf2f(vr[i]);
        }
        const float inv = 1.0f / lsum;
#pragma unroll
        for (int i = 0; i < 64; ++i) mixed[(size_t)n * 1024 + 384 + hq * 64 + i] = f2bf(acc[i] * inv);
    }
}
DEV void ph_gdn_naive(const PRef p, const Ctx& c) {
    const bf16_t* AQ = WSP(const bf16_t, O_AQ); const bf16_t* AK = WSP(const bf16_t, O_AK); const bf16_t* AV = WSP(const bf16_t, O_AV);
    const float* beta = WSP(const float, O_BETA); const float* gg = WSP(const float, O_GG); float* OA = WSP(float, O_OA);
    for (int it = c.gtid; it < 2 * NB * 6 * 64; it += c.gsz) {
        const int e = it & 63, h = (it >> 6) % 6, b = (it / 384) % NB, dir = it / (384 * NB);
        float st[64];
#pragma unroll
        for (int i = 0; i < 64; ++i) st[i] = 0.f;
        for (int s2 = 0; s2 < S; ++s2) {
            const int t = dir == 0 ? s2 : S - 1 - s2, n = b * S + t;
            const float a = expf(gg[((size_t)dir * NTOK + n) * 6 + h]), be = beta[((size_t)dir * NTOK + n) * 6 + h];
            const bf16_t* kr = AK + (size_t)n * 384 + h * 64; const bf16_t* qr = AQ + (size_t)n * 384 + h * 64;
            float kk[64]; float pr = 0.f;
#pragma unroll
            for (int i = 0; i < 64; ++i) { kk[i] = bf2f(kr[i]); pr += kk[i] * st[i]; }
            const float vn = be * (bf2f(AV[(size_t)n * 384 + h * 64 + e]) - a * pr);
            float o = 0.f;
#pragma unroll
            for (int i = 0; i < 64; ++i) { st[i] = a * st[i] + kk[i] * vn; o += st[i] * bf2f(qr[i]); }
            OA[((size_t)dir * NTOK + n) * 384 + h * 64 + e] = o;
        }
    }
}
DEV void ph_hgrn_naive(const PRef p, const Ctx& c) {
    const bf16_t* KIN = WSP(const bf16_t, O_KIN); const bf16_t* CQ = WSP(const bf16_t, O_CQ); const bf16_t* proj = WSP(const bf16_t, O_PROJ); float* OC = WSP(float, O_OC);
    for (int it = c.gtid; it < 2 * NB * 4 * 64; it += c.gsz) {
        const int e = it & 63, h = (it >> 6) % 4, b = (it / 256) % NB, dir = it / (256 * NB);
        float st[64];
#pragma unroll
        for (int i = 0; i < 64; ++i) st[i] = 0.f;
        for (int s2 = 0; s2 < S; ++s2) {
            const int t = dir == 0 ? s2 : S - 1 - s2, n = b * S + t;
            const bf16_t* kr = KIN + ((size_t)dir * NTOK + n) * 256 + h * 64; const bf16_t* qr = CQ + (size_t)n * 256 + h * 64;
            const float v = bf2f(proj[(size_t)n * DINP + C_CI + h * 64 + e]);
            float o = 0.f;
#pragma unroll
            for (int i = 0; i < 64; ++i) { const float k = bf2f(kr[i]); st[i] = (1.0f - k) * st[i] + k * v; o += st[i] * bf2f(qr[i]); }
            OC[((size_t)dir * NTOK + n) * 256 + h * 64 + e] = o;
        }
    }
}
DEV void ph_combine(const PRef p, int l, const Ctx& c) {
    const bf16_t* proj = WSP(const bf16_t, O_PROJ); const float* OA = WSP(const float, O_OA); const float* OC = WSP(const float, O_OC); bf16_t* mixed = WSP(bf16_t, O_MIXED);
    for (int it = c.gtid; it < NTOK * 10; it += c.gsz) {
        const int n = it / 10, j = it % 10; const bool isA = j < 6; const int h = isA ? j : j - 6;
        const float* s0 = isA ? OA + (size_t)n * 384 + h * 64 : OC + (size_t)n * 256 + h * 64;
        const float* s1 = isA ? s0 + (size_t)NTOK * 384 : s0 + (size_t)NTOK * 256;
        const float* nw = (isA ? p.k->in[I_GDNNW] : p.k->in[I_HGNW]) + l * 64;
        const bf16_t* gate = proj + (size_t)n * DINP + (isA ? C_AZ : C_CG) + h * 64;
        float v[64]; float ss = 0.f;
#pragma unroll
        for (int i = 0; i < 64; i += 4) { const f32x4 a = *(const f32x4*)(s0 + i), b2 = *(const f32x4*)(s1 + i);
#pragma unroll
            for (int e = 0; e < 4; ++e) { v[i + e] = a[e] + b2[e]; ss += v[i + e] * v[i + e]; } }
        const float rs = 1.0f / sqrtf(ss * (1.0f / 64.0f) + RMS_EPS);
        bf16_t* dst = mixed + (size_t)n * 1024 + (isA ? 0 : 768) + h * 64;
#pragma unroll
        for (int i = 0; i < 64; i += 2) { const float g0 = bf2f(gate[i]), g1 = bf2f(gate[i + 1]);
            const float a0 = isA ? siluf_(g0) : sigmoidf_(g0), a1 = isA ? siluf_(g1) : sigmoidf_(g1);
            *(unsigned*)(dst + i) = pk2(v[i] * rs * nw[i] * a0, v[i + 1] * rs * nw[i + 1] * a1); }
    }
}
DEV void ph_xattn_naive(const PRef p, int l, const Ctx& c) {
    const bf16_t* QX = WSP(const bf16_t, O_QX); const bf16_t* KM = WSP(const bf16_t, O_KMEM) + (size_t)l * NMEM * D; const bf16_t* VT = WSP(const bf16_t, O_VT) + (size_t)l * NMEM * D;
    bf16_t* OX = WSP(bf16_t, O_MIXED);
    constexpr int QW = XHD / 4;
    for (int it = c.gtid; it < NTOK * XH * 4; it += c.gsz) {
        const int part = it & 3, h = (it >> 2) % XH, n = it / (4 * XH), b = n / S;
        const bf16_t* qr = QX + (size_t)n * D + h * XHD;
        float acc[QW];
#pragma unroll
        for (int i = 0; i < QW; ++i) acc[i] = 0.f;
        float m = -1e30f, lsum = 0.f;
        for (int k = 0; k < MEMT; ++k) {
            const bf16_t* kr = KM + (size_t)(b * MEMT + k) * D + h * XHD;
            float sc = 0.f;
            for (int i = 0; i < XHD; ++i) sc += bf2f(qr[i]) * bf2f(kr[i]);
            if (sc > m) { const float f = exp2f(m - sc); lsum *= f;
#pragma unroll
                for (int i = 0; i < QW; ++i) acc[i] *= f;
                m = sc; }
            const float pe = exp2f(sc - m); lsum += pe;
#pragma unroll
            for (int i = 0; i < QW; ++i) acc[i] += pe * bf2f(VT[((size_t)b * D + h * XHD + part * QW + i) * MEMT + k]);
        }
        const float inv = 1.0f / lsum;
#pragma unroll
        for (int i = 0; i < QW; ++i) OX[(size_t)n * D + h * XHD + part * QW + i] = f2bf(acc[i] * inv);
    }
}

template <int WV> struct WaveOps;
template <> struct WaveOps<1> { static DEV float sum(float v) { return v; } };
#ifndef CPU_TEST
template <> struct WaveOps<64> { static DEV float sum(float v) {
#pragma unroll
    for (int o = 1; o < 64; o <<= 1) v += __shfl_xor(v, o);
    return v; } };
#endif
template <int WV> DEV void ph_ln(const PRef p, const float* g, const float* bta, int mode, int route, const float* wr, int gw, int nw, int lane) {
    constexpr int PER = D / WV / 4;
    float* XF = p.k->out; bf16_t* XB = WSP(bf16_t, O_XB);
    const int* tope_r = WSP(const int, O_TOPE); const float* topw_r = WSP(const float, O_TOPW); const int* pose_r = WSP(const int, O_POSE); const unsigned* cnt = WSP(const unsigned, O_CTL);
    int pstart[NEXP];
    if (mode == 1) { int acc = 0;
#pragma unroll
        for (int e = 0; e < NEXP; ++e) { pstart[e] = acc; acc += (int)((cnt[e] + 255u) >> 8) * 256; } }
    for (int row = gw; row < NTOK; row += nw) {
        f32x4 v[PER]; float s = 0.f;
        float* xr = XF + (size_t)row * D;
#pragma unroll
        for (int j = 0; j < PER; ++j) v[j] = *(const f32x4*)(xr + (j * WV + lane) * 4);
        if (mode == 1) {
            const int e0 = tope_r[row * 2], e1 = tope_r[row * 2 + 1]; const float w0 = topw_r[row * 2], w1 = topw_r[row * 2 + 1];
            int r0 = 0, r1 = 0;
#pragma unroll
            for (int e = 0; e < NEXP; ++e) { if (e == e0) r0 = pstart[e]; if (e == e1) r1 = pstart[e]; }
            r0 += pose_r[row * 2]; r1 += pose_r[row * 2 + 1];
            const bf16_t* y0 = WSP(const bf16_t, O_XG) + (size_t)r0 * D; const bf16_t* y1 = WSP(const bf16_t, O_XG) + (size_t)r1 * D;
#pragma unroll
            for (int j = 0; j < PER; ++j) { const u32x2 a = *(const u32x2*)(y0 + (j * WV + lane) * 4), b2 = *(const u32x2*)(y1 + (j * WV + lane) * 4);
                v[j][0] = DN_ALPHA * v[j][0] + w0 * bf2f((bf16_t)(a.x & 0xffffu)) + w1 * bf2f((bf16_t)(b2.x & 0xffffu));
                v[j][1] = DN_ALPHA * v[j][1] + w0 * bf2f((bf16_t)(a.x >> 16)) + w1 * bf2f((bf16_t)(b2.x >> 16));
                v[j][2] = DN_ALPHA * v[j][2] + w0 * bf2f((bf16_t)(a.y & 0xffffu)) + w1 * bf2f((bf16_t)(b2.y & 0xffffu));
                v[j][3] = DN_ALPHA * v[j][3] + w0 * bf2f((bf16_t)(a.y >> 16)) + w1 * bf2f((bf16_t)(b2.y >> 16)); }
        }
#pragma unroll
        for (int j = 0; j < PER; ++j) s += (v[j][0] + v[j][1]) + (v[j][2] + v[j][3]);
        const float mean = WaveOps<WV>::sum(s) * (1.0f / D); float s2 = 0.f;
#pragma unroll
        for (int j = 0; j < PER; ++j) { v[j] = v[j] - mean; s2 += (v[j][0] * v[j][0] + v[j][1] * v[j][1]) + (v[j][2] * v[j][2] + v[j][3] * v[j][3]); }
        const float rstd = 1.0f / sqrtf(WaveOps<WV>::sum(s2) * (1.0f / D) + LN_EPS);
        float lg[NEXP];
#pragma unroll
        for (int e = 0; e < NEXP; ++e) lg[e] = 0.f;
#pragma unroll
        for (int j = 0; j < PER; ++j) { const int c0 = (j * WV + lane) * 4; const f32x4 gv = *(const f32x4*)(g + c0), bv = *(const f32x4*)(bta + c0);
            f32x4 o = v[j] * rstd * gv + bv; *(f32x4*)(xr + c0) = o; u32x2 w; w.x = pk2(o[0], o[1]); w.y = pk2(o[2], o[3]); *(u32x2*)(XB + (size_t)row * D + c0) = w;
            if (route) {
#pragma unroll
                for (int q = 0; q < 4; ++q) { const f32x4 r0 = *(const f32x4*)(wr + (size_t)(c0 + q) * NEXP), r1 = *(const f32x4*)(wr + (size_t)(c0 + q) * NEXP + 4);
                    lg[0] += o[q] * r0[0]; lg[1] += o[q] * r0[1]; lg[2] += o[q] * r0[2]; lg[3] += o[q] * r0[3]; lg[4] += o[q] * r1[0]; lg[5] += o[q] * r1[1]; lg[6] += o[q] * r1[2]; lg[7] += o[q] * r1[3]; } } }
        if (route) {
#pragma unroll
            for (int e = 0; e < NEXP; ++e) lg[e] = WaveOps<WV>::sum(lg[e]);
            if (lane == 0) {
                int e0 = 0; float m0 = lg[0];
#pragma unroll
                for (int e = 1; e < NEXP; ++e) if (lg[e] > m0) { m0 = lg[e]; e0 = e; }
                int e1 = -1; float m1 = -3e38f;
#pragma unroll
                for (int e = 0; e < NEXP; ++e) if (e != e0 && lg[e] > m1) { m1 = lg[e]; e1 = e; }
                const float w1 = 1.0f / (1.0f + expf(m0 - m1)), w0 = 1.0f - w1;
                int* tope = WSP(int, O_TOPE); float* topw = WSP(float, O_TOPW); int* pose = WSP(int, O_POSE); unsigned* cw = WSP(unsigned, O_CTL);
                tope[row * 2] = e0; tope[row * 2 + 1] = e1; topw[row * 2] = w0; topw[row * 2 + 1] = w1;
#ifndef CPU_TEST
                pose[row * 2] = (int)atomicAdd(cw + e0, 1u); pose[row * 2 + 1] = (int)atomicAdd(cw + e1, 1u);
#else
                pose[row * 2] = (int)cw[e0]++; pose[row * 2 + 1] = (int)cw[e1]++;
#endif
            }
        }
    }
}
DEV void ph_moe_gather(const PRef p, const Ctx& c) {
    const unsigned* cnt = WSP(const unsigned, O_CTL); const int* tope = WSP(const int, O_TOPE); const int* pose = WSP(const int, O_POSE);
    const bf16_t* XB = WSP(const bf16_t, O_XB); bf16_t* XG = WSP(bf16_t, O_XG);
    int pstart[NEXP]; { int acc = 0;
#pragma unroll
        for (int e = 0; e < NEXP; ++e) { pstart[e] = acc; acc += (int)((cnt[e] + 255u) >> 8) * 256; } }
    constexpr int CH = D / 8;
    for (size_t it = c.gtid; it < (size_t)NTOK * 2 * CH; it += c.gsz) {
        const int ch = (int)(it % CH), tk = (int)(it / CH), e = tope[tk];
        int r = 0;
#pragma unroll
        for (int q = 0; q < NEXP; ++q) if (q == e) r = pstart[q];
        r += pose[tk];
        *(u32x4*)(XG + (size_t)r * D + ch * 8) = *(const u32x4*)(XB + (size_t)(tk >> 1) * D + ch * 8);
    }
}
struct Unit { int pm, pn, aux; long aoff, boff; };
struct Gemm { const bf16_t* A; const bf16_t* Bt; int lda, ldb, K; };
constexpr int NXCD = 8, WGM = 8;

struct SchedDense {
    int nM, nN, nwg, G, c, lda, ldb;
    HD void init(int M, int N, int lda_, int ldb_, int G_, int c_) { nM = M / 256; nN = N / 256; nwg = nM * nN; G = G_; c = c_; lda = lda_; ldb = ldb_; }
    HD bool next(int i, Unit& u) const {
        const long L = (long)i * G + c; if (L >= nwg) return false;
        int wgid = (int)L; { const int q = nwg / NXCD, r = nwg % NXCD, xcd = wgid % NXCD, off = wgid / NXCD; wgid = (xcd < r ? xcd * (q + 1) : r * (q + 1) + (xcd - r) * q) + off; }
        const int nig = WGM * nN, gid = wgid / nig, fm = gid * WGM, gsz = (nM - fm) < WGM ? (nM - fm) : WGM;
        u.pm = fm + ((wgid % nig) % gsz); u.pn = (wgid % nig) / gsz; u.aux = u.pm;
        u.aoff = (long)u.pm * 256 * lda * 2; u.boff = (long)u.pn * 256 * ldb * 2; return true;
    }
};
struct SchedKV {
    int G, c;
    HD void init(int G_, int c_) { G = G_; c = c_; }
    HD bool next(int i, Unit& u) const {
        constexpr int nM = NMEM / 256, nN = 2 * D / 256;
        const int L = i * G + c; if (L >= 2 * nM * nN) return false;
        u.aux = L / (nM * nN); u.pm = (L % (nM * nN)) / nN; u.pn = L % nN;
        u.aoff = (long)u.pm * 256 * D * 2; u.boff = ((long)u.aux * 2 * D + u.pn * 256) * D * 2; return true;
    }
};
struct SchedMoe {
    int G, c, t0, t1, nN, which; int tend[NEXP];
    HD void init(const unsigned* cnt, int half, int which_, int G_, int c_) {
        G = G_; c = c_; which = which_; int acc = 0;
        for (int e = 0; e < NEXP; ++e) { acc += (int)((cnt[e] + 255u) >> 8); tend[e] = acc; }
        const int th = (acc + 1) / 2; t0 = half == 0 ? 0 : th; t1 = half == 0 ? th : acc;
        nN = which == 0 ? 2 * FFE / 256 : D / 256;
    }
    HD bool next(int i, Unit& u) const {
        const long L = (long)i * G + c; if (L >= (long)(t1 - t0) * nN) return false;
        const int t = t0 + (int)(L / nN); u.pn = (int)(L % nN); u.pm = t; u.aux = t - t0;
        int e = 0;
        for (int q = 0; q < NEXP - 1; ++q) e += (t >= tend[q]) ? 1 : 0;
        if (which == 0) { u.aoff = (long)t * 256 * D * 2; u.boff = ((long)e * 2 * FFE + u.pn * 256) * D * 2; }
        else { u.aoff = (long)u.aux * 256 * FFE * 2; u.boff = ((long)e * D + u.pn * 256) * FFE * 2; }
        return true;
    }
};

struct EpiStore {
    static constexpr bool PAIR = false; bf16_t* O; int ldc; float scale;
    DEV void apply(const Unit& u, int r, int c, f32x4 v) const { u32x2 w; w.x = pk2(v[0] * scale, v[1] * scale); w.y = pk2(v[2] * scale, v[3] * scale);
        *(u32x2*)(O + (size_t)(u.pm * 256 + r) * ldc + u.pn * 256 + c) = w; }
};
struct EpiResid {
    static constexpr bool PAIR = false; const float* src; float* dst;
    DEV void apply(const Unit& u, int r, int c, f32x4 v) const { const size_t o = (size_t)(u.pm * 256 + r) * D + u.pn * 256 + c; const f32x4 s = *(const f32x4*)(src + o); *(f32x4*)(dst + o) = s * DN_ALPHA + v; }
};
struct EpiKV {
    static constexpr bool PAIR = false; bf16_t* KM; bf16_t* VT;
    DEV void apply(const Unit& u, int r, int c, f32x4 v) const { const int row = u.pm * 256 + r, col = u.pn * 256 + c;
        if (col < D) { u32x2 w; w.x = pk2(v[0], v[1]); w.y = pk2(v[2], v[3]); *(u32x2*)(KM + ((size_t)u.aux * NMEM + row) * D + col) = w; }
        else { const int b = row / MEMT, key = row % MEMT; bf16_t* o = VT + (((size_t)u.aux * NB + b) * D + (col - D)) * MEMT + key;
            o[0] = f2bf(v[0]); o[MEMT] = f2bf(v[1]); o[2 * MEMT] = f2bf(v[2]); o[3 * MEMT] = f2bf(v[3]); } }
};
struct EpiSwiglu {
    static constexpr bool PAIR = true; bf16_t* H; int ldh;
    DEV void apply2(const Unit& u, int r, int c, f32x4 g, f32x4 up) const { u32x2 w; w.x = pk2(siluf_(g[0]) * up[0], siluf_(g[1]) * up[1]); w.y = pk2(siluf_(g[2]) * up[2], siluf_(g[3]) * up[3]);
        *(u32x2*)(H + (size_t)(u.aux * 256 + r) * ldh + u.pn * 128 + c) = w; }
};

#ifdef CPU_TEST
template <class Sched, class Epi> static void gemm_cpu(const Gemm& g, Sched S_, const Epi& E, int G) {
    float* tile = new float[256 * 256];
    for (int c = 0; c < G; ++c) { Sched S2 = S_; S2.c = c; S2.G = G; Unit u;
        for (int i = 0; S2.next(i, u); ++i) {
            const bf16_t* A = (const bf16_t*)((const char*)g.A + u.aoff); const bf16_t* B = (const bf16_t*)((const char*)g.Bt + u.boff);
            for (int r = 0; r < 256; ++r) for (int cc = 0; cc < 256; ++cc) { float a = 0.f; for (int k = 0; k < g.K; ++k) a += bf2f(A[(size_t)r * g.lda + k]) * bf2f(B[(size_t)cc * g.ldb + k]); tile[r * 256 + cc] = a; }
            for (int r = 0; r < 256; ++r) {
                if constexpr (Epi::PAIR) { for (int cc = 0; cc < 128; cc += 4) E.apply2(u, r, cc, *(f32x4*)(tile + r * 256 + cc), *(f32x4*)(tile + r * 256 + 128 + cc)); }
                else { for (int cc = 0; cc < 256; cc += 4) E.apply(u, r, cc, *(f32x4*)(tile + r * 256 + cc)); } } } }
    delete[] tile;
}
#endif
#ifndef CPU_TEST
#define LAS __attribute__((address_space(3)))
typedef short bf16x8 __attribute__((ext_vector_type(8)));
constexpr int BK = 64, HALF = 128, HTB = HALF * BK * 2;
__host__ __device__ __forceinline__ int lds_byte(int r, int c) { const int st = (r >> 4) * 2 + (c >> 5), rr = r & 15, cc = c & 31, ob = rr * 64 + cc * 2; return st * 1024 + (ob ^ (((ob >> 9) & 1) << 5)); }
__host__ __device__ __forceinline__ void stage_rc(int b, int& R, int& C) { const int st = b / 1024, sb = b % 1024, swz = sb ^ (((sb >> 9) & 1) << 5); R = (st >> 1) * 16 + swz / 64; C = (st & 1) * 32 + (swz % 64) / 2; }

template <class Epi> __device__ __forceinline__ void run_epi(const Epi& E, const f32x4 (&acc)[2][2][4][2], const Unit& u, int wr, int wc, int fr, int fq) {
#pragma unroll
    for (int ai = 0; ai < 2; ++ai)
#pragma unroll
        for (int m = 0; m < 4; ++m) { const int r = ai * HALF + wr * 64 + m * 16 + fr;
            if constexpr (Epi::PAIR) {
#pragma unroll
                for (int n = 0; n < 2; ++n) E.apply2(u, r, wc * 32 + n * 16 + 4 * fq, acc[ai][0][m][n], acc[ai][1][m][n]);
                asm volatile("" ::: "memory");
            } else {
#pragma unroll
                for (int bj = 0; bj < 2; ++bj)
#pragma unroll
                    for (int n = 0; n < 2; ++n) E.apply(u, r, bj * HALF + wc * 32 + n * 16 + 4 * fq, acc[ai][bj][m][n]);
                asm volatile("" ::: "memory");
            } }
}

template <class Epi, class Sched>
__device__ __forceinline__ void gemm_phase(LAS unsigned char* lds, const int tid  , const Gemm g, const Sched& S, const Epi& E) {
    const int wid = __builtin_amdgcn_readfirstlane(tid >> 6), lane = tid & 63, wr = wid >> 2, wc = wid & 3, fr = lane & 15, fq = lane >> 4;
    const int K = g.K, nt = K / BK;
    unsigned voffA[2], voffB[2];
#pragma unroll
    for (int i = 0; i < 2; ++i) { int R, C; stage_rc(tid * 16 + i * 8192, R, C); voffA[i] = (unsigned)(R * g.lda + C) * 2u; voffB[i] = (unsigned)(R * g.ldb + C) * 2u; }
    const size_t kstep = (size_t)(BK * 2);
    const size_t hstepA = (size_t)HALF * g.lda * 2, hstepB = (size_t)HALF * g.ldb * 2;
    const unsigned ldsw = (unsigned)wid * 1024u;
    const int aoff = lds_byte(wr * 64 + fr, fq * 8), boff = lds_byte(wc * 32 + fr, fq * 8);
#define PG8_SA(b, h) (((b) * 2 + (h)) * HTB)
#define PG8_SB(b, h) ((4 + (b) * 2 + (h)) * HTB)
#define PG8_STAGE(bufoff, gbase, voff) do { _Pragma("unroll") for (int _i = 0; _i < 2; ++_i) \
        __builtin_amdgcn_global_load_lds((const unsigned*)((const char*)(gbase) + (voff)[_i]), (LAS unsigned*)(lds + (bufoff) + ldsw + _i * 8192), 16, 0, 0); } while (0)
#define PG8_LDA(dst, b, h) do { _Pragma("unroll") for (int m = 0; m < 4; ++m) _Pragma("unroll") for (int k = 0; k < 2; ++k) dst[m][k] = *(const LAS bf16x8*)(lds + PG8_SA(b, h) + aoff + m * 2048 + k * 1024); } while (0)
#define PG8_LDB(dst, b, h) do { _Pragma("unroll") for (int n = 0; n < 2; ++n) _Pragma("unroll") for (int k = 0; k < 2; ++k) dst[n][k] = *(const LAS bf16x8*)(lds + PG8_SB(b, h) + boff + n * 2048 + k * 1024); } while (0)
#define PG8_MMA(ai, bj, At, Bt) do { __builtin_amdgcn_s_setprio(1); _Pragma("unroll") for (int m = 0; m < 4; ++m) _Pragma("unroll") for (int n = 0; n < 2; ++n) _Pragma("unroll") for (int k = 0; k < 2; ++k) \
        acc[ai][bj][m][n] = __builtin_amdgcn_mfma_f32_16x16x32_bf16(Bt[n][k], At[m][k], acc[ai][bj][m][n], 0, 0, 0); __builtin_amdgcn_s_setprio(0); } while (0)
#define PG8_WAIT_V(n) asm volatile("s_waitcnt vmcnt(" #n ")" ::: "memory")
#define PG8_WAIT_L(n) asm volatile("s_waitcnt lgkmcnt(" #n ")" ::: "memory")
#define PG8_BAR __builtin_amdgcn_s_barrier()
#define PG8_SCHED __builtin_amdgcn_sched_barrier(0)
    Unit cur, nxt; int ui = 0;
    if (!S.next(0, cur)) return;
    f32x4 acc[2][2][4][2];
#pragma unroll
    for (int a = 0; a < 2; ++a)
#pragma unroll
        for (int b = 0; b < 2; ++b)
#pragma unroll
            for (int m = 0; m < 4; ++m)
#pragma unroll
                for (int n = 0; n < 2; ++n) acc[a][b][m][n] = (f32x4){0.f, 0.f, 0.f, 0.f};
    bf16x8 At[4][2], B0[2][2], B1[2][2];
    const char* cA = (const char*)g.A + cur.aoff; const char* cB = (const char*)g.Bt + cur.boff;
    PG8_STAGE(PG8_SB(0, 0), cB, voffB); PG8_STAGE(PG8_SB(0, 1), cB + hstepB, voffB); PG8_STAGE(PG8_SA(0, 0), cA, voffA); PG8_STAGE(PG8_SA(0, 1), cA + hstepA, voffA);
    if (wr == 1) PG8_BAR;
    PG8_WAIT_V(2); PG8_BAR;
    PG8_STAGE(PG8_SB(1, 0), cB + kstep, voffB); PG8_STAGE(PG8_SA(1, 0), cA + kstep, voffA); PG8_STAGE(PG8_SB(1, 1), cB + hstepB + kstep, voffB);
    PG8_WAIT_V(6); PG8_BAR;
    for (;;) {
        const bool has_next = S.next(ui + 1, nxt);
        const char* nA = has_next ? (const char*)g.A + nxt.aoff : cA; const char* nB = has_next ? (const char*)g.Bt + nxt.boff : cB;
        for (int t = 0; t < nt; t += 2) {
            const bool last = (t == nt - 2);
            const char* a1 = cA + (size_t)(t + 1) * kstep;
            const char* a2 = last ? nA : cA + (size_t)(t + 2) * kstep; const char* b2 = last ? nB : cB + (size_t)(t + 2) * kstep;
            const char* a3 = a2 + kstep; const char* b3 = b2 + kstep;
            PG8_LDB(B0, 0, 0); PG8_LDB(B1, 0, 1); PG8_SCHED; PG8_LDA(At, 0, 0); PG8_STAGE(PG8_SA(1, 1), a1 + hstepA, voffA);
            PG8_WAIT_V(8); PG8_WAIT_L(0); PG8_BAR; PG8_MMA(0, 0, At, B0); PG8_MMA(0, 1, At, B1); PG8_BAR; PG8_SCHED;
            PG8_LDA(At, 0, 1); PG8_STAGE(PG8_SB(0, 0), b2, voffB); PG8_STAGE(PG8_SB(0, 1), b2 + hstepB, voffB); PG8_STAGE(PG8_SA(0, 0), a2, voffA);
            PG8_WAIT_V(8); PG8_WAIT_L(0); PG8_BAR; PG8_MMA(1, 0, At, B0); PG8_MMA(1, 1, At, B1); PG8_BAR; PG8_SCHED;
            PG8_LDB(B0, 1, 0); PG8_LDB(B1, 1, 1); PG8_SCHED; PG8_LDA(At, 1, 0); PG8_STAGE(PG8_SA(0, 1), a2 + hstepA, voffA);
            PG8_WAIT_V(8); PG8_WAIT_L(0); PG8_BAR; PG8_MMA(0, 0, At, B0); PG8_MMA(0, 1, At, B1); PG8_BAR; PG8_SCHED;
            PG8_LDA(At, 1, 1); PG8_STAGE(PG8_SB(1, 0), b3, voffB); PG8_STAGE(PG8_SB(1, 1), b3 + hstepB, voffB); PG8_STAGE(PG8_SA(1, 0), a3, voffA);
            PG8_WAIT_V(8); PG8_WAIT_L(0); PG8_BAR; PG8_MMA(1, 0, At, B0); PG8_MMA(1, 1, At, B1); PG8_BAR; PG8_SCHED;
        }
        if (wr == 0) PG8_BAR;
        run_epi(E, acc, cur, wr, wc, fr, fq);
        if (!has_next) break;
#pragma unroll
        for (int a = 0; a < 2; ++a)
#pragma unroll
            for (int b = 0; b < 2; ++b)
#pragma unroll
                for (int m = 0; m < 4; ++m)
#pragma unroll
                    for (int n = 0; n < 2; ++n) acc[a][b][m][n] = (f32x4){0.f, 0.f, 0.f, 0.f};
        cur = nxt; cA = nA; cB = nB; ++ui;
        if (wr == 1) PG8_BAR;
    }
    PG8_WAIT_V(0);
    PG8_BAR;
#undef PG8_SA
#undef PG8_SB
#undef PG8_STAGE
#undef PG8_LDA
#undef PG8_LDB
#undef PG8_MMA
#undef PG8_WAIT_V
#undef PG8_WAIT_L
#undef PG8_BAR
#undef PG8_SCHED
}
#endif
#ifndef CPU_TEST
namespace attn_body {
using bf16=__hip_bfloat16;
using bf16x8=__attribute__((ext_vector_type(8)))short;
using s16x4=__attribute__((ext_vector_type(4)))short;
using f32x16=__attribute__((ext_vector_type(16)))float;
using u32x4=__attribute__((ext_vector_type(4)))unsigned;
constexpr int SEQ=::S,D=64,QP=384,KP=128,VP=::DINP,OP=1024;
constexpr int NW=8,QBLK=32,QB=QBLK*NW,KVBLK=64,NQB=SEQ/QB;
constexpr int ATTN_UNIT_ROWS=QB;
__device__ __forceinline__ int crow(int r,int hi){return (r&3)+8*(r>>2)+4*hi;}
#define SBAR() __builtin_amdgcn_sched_barrier(0)
constexpr int NSLOT=3, SLOTB=8192;
constexpr int LDS_K=0, LDS_V=NSLOT*SLOTB, LDS_WS=2*NSLOT*SLOTB, LDS_OST=LDS_WS+NW*64*4, LDS_BYTES=LDS_OST+NW*4096;
constexpr float C2=0.125f*1.4426950408889634f;
__device__ __forceinline__ void glds16(const void*gsrc,unsigned lds_dst){unsigned keep;
  asm volatile("s_mov_b32 %0, m0\n\ts_mov_b32 m0, %2\n\ts_nop 0\n\tglobal_load_lds_dwordx4 %1, off\n\ts_mov_b32 m0, %0":"=&s"(keep):"v"(gsrc),"s"(lds_dst):"memory");}
__device__ __forceinline__ float max3f(float a,float b,float c){float r;asm("v_max3_f32 %0, %1, %2, %3":"=v"(r):"v"(a),"v"(b),"v"(c));return r;}
__device__ __forceinline__ float max2f(float a,float b){float r;asm("v_max_f32_e32 %0, %1, %2":"=v"(r):"v"(a),"v"(b));return r;}
__device__ __forceinline__ float fadd_s(float a,float b){float r;asm("v_add_f32_e32 %0, %1, %2":"=v"(r):"v"(a),"v"(b));return r;}
__device__ __forceinline__ float fsub_s(float a,float b){float r;asm("v_sub_f32_e32 %0, %1, %2":"=v"(r):"v"(a),"v"(b));return r;}
typedef float f32x2_t __attribute__((ext_vector_type(2))); typedef __bf16 bf16x2_t __attribute__((ext_vector_type(2)));
__device__ __forceinline__ unsigned cvtpk_s(float lo,float hi){f32x2_t v={lo,hi};bf16x2_t b=__builtin_convertvector(v,bf16x2_t);return __builtin_bit_cast(unsigned,b);}
#define WAIT_BAR(N) asm volatile("s_waitcnt vmcnt(" #N ") lgkmcnt(0)\n\ts_barrier":::"memory")

__device__ __forceinline__ void qkt(f32x16&p0,f32x16&p1,const char*Kslot,const bf16x8*qr,const f32x16&negm,int r32,int hi){
  const char*kb=Kslot+hi*1024+r32*16;
  #pragma unroll
  for(int d0=0;d0<4;++d0){
    const bf16x8 b0=*reinterpret_cast<const bf16x8*>(kb+d0*2048);
    const bf16x8 b1=*reinterpret_cast<const bf16x8*>(kb+d0*2048+512);
    if(d0==0){p0=__builtin_amdgcn_mfma_f32_32x32x16_bf16(b0,qr[0],negm,0,0,0);p1=__builtin_amdgcn_mfma_f32_32x32x16_bf16(b1,qr[0],negm,0,0,0);}
    else{p0=__builtin_amdgcn_mfma_f32_32x32x16_bf16(b0,qr[d0],p0,0,0,0);p1=__builtin_amdgcn_mfma_f32_32x32x16_bf16(b1,qr[d0],p1,0,0,0);}}
}
typedef __attribute__((address_space(3))) const char* lds_cptr;
typedef short v4i16_t __attribute__((ext_vector_type(4)));
__device__ __forceinline__ void kload8(bf16x8*kf,lds_cptr kp){
  kf[0]=*(const __attribute__((address_space(3))) bf16x8*)(kp);      kf[1]=*(const __attribute__((address_space(3))) bf16x8*)(kp+512);
  kf[2]=*(const __attribute__((address_space(3))) bf16x8*)(kp+2048); kf[3]=*(const __attribute__((address_space(3))) bf16x8*)(kp+2560);
  kf[4]=*(const __attribute__((address_space(3))) bf16x8*)(kp+4096); kf[5]=*(const __attribute__((address_space(3))) bf16x8*)(kp+4608);
  kf[6]=*(const __attribute__((address_space(3))) bf16x8*)(kp+6144); kf[7]=*(const __attribute__((address_space(3))) bf16x8*)(kp+6656);
}
__device__ __forceinline__ void kload2(bf16x8*kf,lds_cptr kp,int j){ kf[2*j]=*(const __attribute__((address_space(3))) bf16x8*)(kp+j*2048); kf[2*j+1]=*(const __attribute__((address_space(3))) bf16x8*)(kp+j*2048+512); }
__device__ __forceinline__ s16x4 vtr(lds_cptr p){ return __builtin_bit_cast(s16x4,__builtin_amdgcn_ds_read_tr16_b64_v4i16((__attribute__((address_space(3))) v4i16_t*)p)); }
__device__ __forceinline__ float rowmax(const f32x16&p0,const f32x16&p1){
  float a=max3f(p0[0],p0[1],p1[0]),b=max3f(p0[2],p0[3],p1[1]);a=max3f(a,p1[2],p1[3]);
  #pragma unroll
  for(int r=4;r<16;r+=4){a=max3f(a,p0[r],p0[r+1]);b=max3f(b,p0[r+2],p0[r+3]);a=max3f(a,p1[r],p1[r+1]);b=max3f(b,p1[r+2],p1[r+3]);}
  const float m=max2f(a,b);
  auto rr=__builtin_amdgcn_permlane32_swap(__float_as_uint(m),__float_as_uint(m),false,false);
  return max2f(__uint_as_float(rr[0]),__uint_as_float(rr[1]));
}
__device__ __forceinline__ void pv(f32x16*o,int vb,bf16x8 pa0,bf16x8 pa1,bf16x8 pa2,bf16x8 pa3){
  #pragma unroll
  for(int d0=0;d0<2;++d0){s16x4 lo[4],hi[4];
    #pragma unroll
    for(int ks=0;ks<4;++ks){
      asm volatile("ds_read_b64_tr_b16 %0,%1 offset:%c2":"=&v"(lo[ks]):"v"(vb),"i"(d0*4096+ks*1024):"memory");
      asm volatile("ds_read_b64_tr_b16 %0,%1 offset:%c2":"=&v"(hi[ks]):"v"(vb),"i"(d0*4096+ks*1024+512):"memory");}
    asm volatile("s_waitcnt lgkmcnt(0)":::"memory");SBAR();
    #define PK(k) (bf16x8){lo[k][0],lo[k][1],lo[k][2],lo[k][3],hi[k][0],hi[k][1],hi[k][2],hi[k][3]}
    o[d0]=__builtin_amdgcn_mfma_f32_32x32x16_bf16(pa0,PK(0),o[d0],0,0,0);
    o[d0]=__builtin_amdgcn_mfma_f32_32x32x16_bf16(pa1,PK(1),o[d0],0,0,0);
    o[d0]=__builtin_amdgcn_mfma_f32_32x32x16_bf16(pa2,PK(2),o[d0],0,0,0);
    o[d0]=__builtin_amdgcn_mfma_f32_32x32x16_bf16(pa3,PK(3),o[d0],0,0,0);
    #undef PK
  }
}

#ifndef ATTN_STORE16
#define ATTN_STORE16(p,v) (*(u32x4*)(p)=(v))
#endif
template<int THRL> __device__ __forceinline__ void attn_unit(int b,int h,int hkv,int qb,const bf16*Q,const bf16*__restrict__ K,const bf16*__restrict__ V,bf16*O,char*shm){
  const int tid=threadIdx.x,lane=tid&63,r32=lane&31,hi=lane>>5; const int wid=__builtin_amdgcn_readfirstlane(tid>>6);
  const long rowbase=(long)b*SEQ; const int q0=qb*QB;
  const bf16*Qw=Q+(rowbase+q0+wid*QBLK)*QP+h*D;
  const bf16*Kh=K+rowbase*KP+hkv*D,*Vh=V+rowbase*VP+hkv*D;
  const unsigned lds0=(unsigned)(uintptr_t)shm;
  float*wsf=(float*)(shm+LDS_WS)+wid*64;
  const bf16*ksrc=Kh+(long)lane*KP+wid*8;
  const bf16*vsrc=Vh+(long)(16*(wid&3)+(lane>>2))*VP+(wid>>2)*32+(lane&3)*8;
  const unsigned kdst=lds0+LDS_K+wid*1024, vdst=lds0+LDS_V+wid*1024;
  #define DMA_K(t,slot) glds16(ksrc+(long)(t)*KVBLK*KP,(unsigned)__builtin_amdgcn_readfirstlane(kdst+(slot)))
  #define DMA_V(t,slot) glds16(vsrc+(long)(t)*KVBLK*VP,(unsigned)__builtin_amdgcn_readfirstlane(vdst+(slot)))
  const int vb0=(int)(lds0+LDS_V)+((lane>>4)&1)*32+(lane&3)*8+(4*hi+((lane&15)>>2))*64;
  const char*Kbase=shm+LDS_K; bf16x8 kf[8];
  const lds_cptr shm3=(lds_cptr)shm; const lds_cptr kp0=shm3+LDS_K+hi*1024+r32*16; const lds_cptr vp0=shm3+LDS_V+((lane>>4)&1)*32+(lane&3)*8+(4*hi+((lane&15)>>2))*64;
  const int NT=SEQ/KVBLK;
  DMA_K(0,0);DMA_V(0,0);DMA_K(1,SLOTB);
  bf16x8 qr[4];
  #pragma unroll
  for(int d0=0;d0<4;++d0)qr[d0]=*reinterpret_cast<const bf16x8*>(&Qw[(long)r32*QP+d0*16+hi*8]);
  float mhat=0.f,l_reg=0.f;f32x16 o[2];o[0]=f32x16{};o[1]=f32x16{};f32x16 negm=f32x16{};asm volatile("":"+v"(negm));
    #define CMASK(P0,P1,t) do{}while(0)
  bool resc=false;
  #define START(P0,P1) do{ const float rm=rowmax(P0,P1); resc=false; \
    { const float dl=rm; mhat=fadd_s(mhat,dl); \
      _Pragma("unroll") for(int r=0;r<16;++r){P0[r]=fsub_s(P0[r],dl);P1[r]=fsub_s(P1[r],dl);} \
      _Pragma("unroll") for(int r=0;r<16;++r)negm[r]=-mhat; asm volatile("":"+v"(negm)); } \
    _Pragma("unroll") for(int r=0;r<16;++r)P0[r]=__builtin_amdgcn_exp2f(P0[r]); }while(0)
  #define RESC() do{ if(resc){ asm volatile("s_waitcnt lgkmcnt(0)":::"memory"); \
      _Pragma("unroll") for(int d_=0;d_<2;++d_) _Pragma("unroll") for(int r=0;r<16;++r)o[d_][r]*=wsf[crow(r,hi)]; } }while(0)
  f32x16 pA0,pA1,pB0,pB1;
  int sl_prev=0,sl_cur=0,sl_next=SLOTB;
  #define ROT() do{sl_prev=sl_cur;sl_cur=sl_next;sl_next=(sl_next==(NSLOT-1)*SLOTB)?0:sl_next+SLOTB;}while(0)
  DMA_K(2,2*SLOTB);
  WAIT_BAR(3);
  qkt(pA0,pA1,Kbase,qr,negm,r32,hi);asm volatile("s_nop 15\n\ts_nop 7":"+v"(pA0),"+v"(pA1));CMASK(pA0,pA1,0);
  START(pA0,pA1);
  _Pragma("unroll") for(int r=0;r<16;++r)pA1[r]=__builtin_amdgcn_exp2f(pA1[r]);
  WAIT_BAR(0);
  DMA_K(3,0);DMA_V(1,SLOTB);
  ROT();
  kload8(kf,kp0+sl_cur);
  WAIT_BAR(2);
  s16x4 vlo[8],vhi[8]; u32x4 pw0,pw1,pw2,pw3;
  #define PKW(P,B) cvtpk_s(P[B],P[B+1])
  #define PAF(k) __builtin_bit_cast(bf16x8,pw##k)
  #define VFR(i) (bf16x8){vlo[i][0],vlo[i][1],vlo[i][2],vlo[i][3],vhi[i][0],vhi[i][1],vhi[i][2],vhi[i][3]}
  #define PIN(x) asm volatile("":"+v"(x))
  #define MX3(a,b,c) __builtin_fmaxf(__builtin_fmaxf((a),(b)),(c))
  #define GAPA(MF,A0,A1,A2,A3,W0,W1,PW) do{ MF; sacc+=A0; sacc+=A1; sacc+=A2; sacc+=A3; PIN(sacc); W0; W1; PIN(PW); SBAR(); }while(0)
  #define EX(v) __builtin_amdgcn_exp2f(v)
  #define GAPB(MF,X,B) do{ MF; X[B]=EX(X[B]); X[B+1]=EX(X[B+1]); X[B+2]=EX(X[B+2]); X[B+3]=EX(X[B+3]); PIN(X); SBAR(); }while(0)
  #define VRD(i) do{ vlo[i]=vtr(vp_+(((i)>>2)*4096+((i)&3)*1024)); vhi[i]=vtr(vp_+(((i)>>2)*4096+((i)&3)*1024+512)); }while(0)
  #define KRD(G,j) do{ if(G){ kload2(kf,kp0+sl_next,j); SBAR(); } }while(0)
  #define STEP(C0,C1,P0,P1,t,GK,GV,GL) do{ SBAR(); \
    const lds_cptr vp_=vp0+sl_prev; \
    VRD(0); SBAR(); float sacc=(P0[0]+P0[1]); \
    GAPA(C0=__builtin_amdgcn_mfma_f32_32x32x16_bf16(kf[0],qr[0],negm,0,0,0), P0[2],P0[3],P0[4],P0[5],     pw0[0]=PKW(P0,0), pw0[1]=PKW(P0,2), pw0); \
    VRD(4); SBAR(); GAPA(C1=__builtin_amdgcn_mfma_f32_32x32x16_bf16(kf[1],qr[0],negm,0,0,0), P0[6],P0[7],P0[8],P0[9],     pw0[2]=PKW(P0,4), pw0[3]=PKW(P0,6), pw0); \
    VRD(1); SBAR(); GAPA(C0=__builtin_amdgcn_mfma_f32_32x32x16_bf16(kf[2],qr[1],C0,0,0,0),   P0[10],P0[11],P0[12],P0[13], pw1[0]=PKW(P0,8), pw1[1]=PKW(P0,10), pw1); \
    VRD(5); SBAR(); GAPA(C1=__builtin_amdgcn_mfma_f32_32x32x16_bf16(kf[3],qr[1],C1,0,0,0),   P0[14],P0[15],P1[0],P1[1],   pw1[2]=PKW(P0,12),pw1[3]=PKW(P0,14), pw1); \
    VRD(2); SBAR(); GAPA(C0=__builtin_amdgcn_mfma_f32_32x32x16_bf16(kf[4],qr[2],C0,0,0,0),   P1[2],P1[3],P1[4],P1[5],     pw2[0]=PKW(P1,0), pw2[1]=PKW(P1,2), pw2); \
    VRD(6); SBAR(); GAPA(C1=__builtin_amdgcn_mfma_f32_32x32x16_bf16(kf[5],qr[2],C1,0,0,0),   P1[6],P1[7],P1[8],P1[9],     pw2[2]=PKW(P1,4), pw2[3]=PKW(P1,6), pw2); \
    VRD(3); SBAR(); GAPA(C0=__builtin_amdgcn_mfma_f32_32x32x16_bf16(kf[6],qr[3],C0,0,0,0),   P1[10],P1[11],P1[12],P1[13], pw3[0]=PKW(P1,8), pw3[1]=PKW(P1,10), pw3); \
    VRD(7); SBAR(); GAPA(C1=__builtin_amdgcn_mfma_f32_32x32x16_bf16(kf[7],qr[3],C1,0,0,0),   P1[14],P1[15],0.f,0.f,       pw3[2]=PKW(P1,12),pw3[3]=PKW(P1,14), pw3); \
    l_reg+=sacc; \
    if(GK){DMA_K((t)+3,sl_cur);} if(GV){DMA_V((t)+1,sl_next);} \
    CMASK(C0,C1,t); \
    { float a=MX3(C0[0],C0[1],C1[0]),b=MX3(C0[2],C0[3],C1[1]); a=MX3(a,C1[2],C1[3]); \
      _Pragma("unroll") for(int r=4;r<16;r+=4){a=MX3(a,C0[r],C0[r+1]);b=MX3(b,C0[r+2],C0[r+3]);a=MX3(a,C1[r],C1[r+1]);b=MX3(b,C1[r+2],C1[r+3]);} \
      float rm=__builtin_fmaxf(a,b); { auto rr=__builtin_amdgcn_permlane32_swap(__float_as_uint(rm),__float_as_uint(rm),false,false); rm=__builtin_fmaxf(__uint_as_float(rr[0]),__uint_as_float(rr[1])); } \
      resc=false; \
      if(__builtin_expect(__any(rm>(float)THRL),0)){ const float dl=__builtin_fmaxf(rm,0.f); mhat+=dl; \
        _Pragma("unroll") for(int r=0;r<16;++r){C0[r]-=dl;C1[r]-=dl;} \
        _Pragma("unroll") for(int r=0;r<16;++r)negm[r]=-mhat; asm volatile("":"+v"(negm)); \
        const float f=__builtin_amdgcn_exp2f(-dl); l_reg*=f; if(hi==0)wsf[r32]=f; resc=true; } } \
    SBAR(); \
    GAPB(o[0]=__builtin_amdgcn_mfma_f32_32x32x16_bf16(PAF(0),VFR(0),o[0],0,0,0), C0,0); \
    GAPB(o[1]=__builtin_amdgcn_mfma_f32_32x32x16_bf16(PAF(0),VFR(4),o[1],0,0,0), C0,4); \
    KRD(GL,0); GAPB(o[0]=__builtin_amdgcn_mfma_f32_32x32x16_bf16(PAF(1),VFR(1),o[0],0,0,0), C0,8); \
    KRD(GL,1); GAPB(o[1]=__builtin_amdgcn_mfma_f32_32x32x16_bf16(PAF(1),VFR(5),o[1],0,0,0), C0,12); \
    KRD(GL,2); GAPB(o[0]=__builtin_amdgcn_mfma_f32_32x32x16_bf16(PAF(2),VFR(2),o[0],0,0,0), C1,0); \
    KRD(GL,3); GAPB(o[1]=__builtin_amdgcn_mfma_f32_32x32x16_bf16(PAF(2),VFR(6),o[1],0,0,0), C1,4); \
    GAPB(o[0]=__builtin_amdgcn_mfma_f32_32x32x16_bf16(PAF(3),VFR(3),o[0],0,0,0), C1,8); \
    GAPB(o[1]=__builtin_amdgcn_mfma_f32_32x32x16_bf16(PAF(3),VFR(7),o[1],0,0,0), C1,12); \
    }while(0)
  int t=1;
  #undef CMASK
  #define CMASK(P0,P1,t) do{}while(0)
  for(;t+5<NT;t+=2){
    STEP(pB0,pB1,pA0,pA1,t,true,true,true);     WAIT_BAR(2); RESC(); ROT();
    STEP(pA0,pA1,pB0,pB1,t+1,true,true,true);   WAIT_BAR(2); RESC(); ROT();
  }
  #undef CMASK
  #define CMASK(P0,P1,t) do{}while(0)
  #define ENDW(tt) do{ if((tt)+3<NT){WAIT_BAR(2);} else if((tt)+2<NT){WAIT_BAR(1);} else {WAIT_BAR(0);} }while(0)
  for(;t+1<NT;t+=2){
    STEP(pB0,pB1,pA0,pA1,t,(t+3<NT),(t+1<NT),(t+1<NT));       ENDW(t);   RESC(); ROT();
    STEP(pA0,pA1,pB0,pB1,t+1,(t+4<NT),(t+2<NT),(t+2<NT));     ENDW(t+1); RESC(); ROT();
  }
  STEP(pB0,pB1,pA0,pA1,NT-1,false,false,false); RESC();
  { float sacc=pB0[0]+pB0[1]; _Pragma("unroll") for(int r=2;r<16;++r)sacc+=pB0[r]; _Pragma("unroll") for(int r=0;r<16;++r)sacc+=pB1[r]; l_reg+=sacc;
    pw0=(u32x4){PKW(pB0,0),PKW(pB0,2),PKW(pB0,4),PKW(pB0,6)};pw1=(u32x4){PKW(pB0,8),PKW(pB0,10),PKW(pB0,12),PKW(pB0,14)};pw2=(u32x4){PKW(pB1,0),PKW(pB1,2),PKW(pB1,4),PKW(pB1,6)};pw3=(u32x4){PKW(pB1,8),PKW(pB1,10),PKW(pB1,12),PKW(pB1,14)};
    SBAR(); pv(o,vb0+sl_cur,PAF(0),PAF(1),PAF(2),PAF(3)); }
  #undef PKW
  #undef PAF
  #undef VFR
  #undef PIN
  #undef MX3
  #undef GAPA
  #undef GAPB
  #undef EX
  #undef VRD
  #undef KRD
  #undef STEP
  #undef ENDW
  {auto rr=__builtin_amdgcn_permlane32_swap(__float_as_uint(l_reg),__float_as_uint(l_reg),false,false);l_reg=__uint_as_float(rr[0])+__uint_as_float(rr[1]);}
  if(hi==0)wsf[32+r32]=l_reg;asm volatile("s_waitcnt lgkmcnt(0)":::"memory");
  float rli[16];
  #pragma unroll
  for(int r=0;r<16;++r)rli[r]=__builtin_amdgcn_rcpf(wsf[32+crow(r,hi)]);
  bf16*Ow=O+(rowbase+q0+wid*QBLK)*OP+h*D;
  { bf16*stg=(bf16*)(shm+LDS_OST)+wid*2048;
    #pragma unroll
    for(int r=0;r<16;++r){const int orow=crow(r,hi);
      #pragma unroll
      for(int d0=0;d0<2;++d0)stg[orow*64+d0*32+r32]=__float2bfloat16(o[d0][r]*rli[r]);}
    asm volatile("s_waitcnt lgkmcnt(0)":::"memory");
    #pragma unroll
    for(int i=0;i<4;++i){const int row=i*8+(lane>>3),ch=lane&7; const u32x4 v=*(const u32x4*)(stg+row*64+ch*8); ATTN_STORE16(Ow+(long)row*OP+ch*8,v);} }
  asm volatile("s_waitcnt lgkmcnt(0)\n\ts_barrier":::"memory");
  #undef DMA_K
  #undef DMA_V
  #undef CMASK
  #undef START
  #undef RESC
  #undef ROT
}
constexpr int ATTN_LDS_BYTES=LDS_BYTES;
struct AttnTensors { const bf16* Q; const bf16* K; const bf16* V; bf16* O; };
constexpr int N_UNITS=::NB*6*(SEQ/QB);
template<int THRL=8> __device__ __forceinline__ void attn_phase(char*lds,const AttnTensors&T,int G,int blk){
  for(int u=blk;u<N_UNITS;u+=G){ const int qb=u%(SEQ/QB), bh=u/(SEQ/QB), hq=bh%6, b=bh/6; attn_unit<THRL>(b,hq,hq/3,qb,T.Q,T.K,T.V,T.O,lds); }
}
#undef SBAR
#undef WAIT_BAR
}

#endif
constexpr int STEPS_PER_LAYER = 16, N_STEPS = 2 + 2 * STEPS_PER_LAYER;
struct Exec {
    Ctx c; int G, blk, gw, nw, lane, tid;
#ifndef CPU_TEST
    LAS unsigned char* lds; unsigned char* lds_generic;
#endif
};
#ifdef CPU_TEST
#define RUN_GEMM(g, S, E) gemm_cpu(g, S, E, X.G)
constexpr int WVW = 1;
#else
#define RUN_GEMM(g, S, E) gemm_phase(X.lds, X.tid, g, S, E)
constexpr int WVW = 64;
#endif
constexpr HD bool step_is_empty(int step) { if (step < 2) return false; const int l = (step - 2) / STEPS_PER_LAYER, s = (step - 2) % STEPS_PER_LAYER; return (l % 2 == 0) && (s >= 12 && s <= 14); }

#ifdef STEP_SET
#define EN(k) (((STEP_SET) >> (k)) & 1)
#else
#define EN(k) 1
#endif
HD int rot_id(int gtid, int gsz, int off) { long v = (long)gsz - 1 - gtid - (off % gsz); if (v < 0) v += gsz; return (int)v; }
DEV void run_step(const PRef p, int step, const Exec& X) {
    const Ctx& c = X.c;
    if (step == 0) { if (EN(16)) ph_prologue(p, c); return; }
    if (step == 1) { if (!EN(17)) return; Gemm g{WSP(const bf16_t, O_MEMB), WSP(const bf16_t, O_XKV_T), D, D, D}; SchedKV S; S.init(X.G, X.blk); EpiKV E{WSP(bf16_t, O_KMEM), WSP(bf16_t, O_VT)}; RUN_GEMM(g, S, E); return; }
    const int l = (step - 2) / STEPS_PER_LAYER, s = (step - 2) % STEPS_PER_LAYER; const bool moe = (l % 2) == 1;
    switch (s) {
    case 0: if (EN(0)) { Gemm g{WSP(const bf16_t, O_XB), WSP(const bf16_t, O_WIN_T) + (size_t)l * DINP * D, D, D, D}; SchedDense S; S.init(NTOK, DINP, D, D, X.G, X.blk);
        EpiStore E{WSP(bf16_t, O_PROJ), DINP, 1.0f}; RUN_GEMM(g, S, E); } break;
    case 1: if (EN(1)) ph_prep(p, l, c); break;
    case 2: if (EN(2)) {
#ifdef CPU_TEST
        ph_attn_naive(p, c);
#else
        { const attn_body::AttnTensors AT{(const attn_body::bf16*)WSP(const bf16_t, O_QB), (const attn_body::bf16*)WSP(const bf16_t, O_KB), (const attn_body::bf16*)(WSP(const bf16_t, O_PROJ) + C_BV), (attn_body::bf16*)(WSP(bf16_t, O_MIXED) + 384)};
          attn_body::attn_phase<8>((char*)X.lds_generic, AT, X.G, X.blk); }
#endif
        Ctx c2{rot_id(c.gtid, c.gsz, 0), c.gsz}; ph_gdn_naive(p, c2);
        Ctx c3{rot_id(c.gtid, c.gsz, 4096), c.gsz}; ph_hgrn_naive(p, c3); } break;
    case 3: if (EN(3)) ph_combine(p, l, c); break;
    case 4: if (EN(4)) { Gemm g{WSP(const bf16_t, O_MIXED), WSP(const bf16_t, O_WOUT_T) + (size_t)l * D * MIXW, MIXW, MIXW, MIXW}; SchedDense S; S.init(NTOK, D, MIXW, MIXW, X.G, X.blk);
        EpiResid E{l == 0 ? p.k->in[I_X] : p.k->out, p.k->out}; RUN_GEMM(g, S, E); } break;
    case 5: if (EN(5)) ph_ln<WVW>(p, p.k->in[I_LN1G] + l * D, p.k->in[I_LN1B] + l * D, 0, 0, nullptr, X.gw, X.nw, X.lane); break;
    case 6: if (EN(6)) { Gemm g{WSP(const bf16_t, O_XB), WSP(const bf16_t, O_XQ_T) + (size_t)l * D * D, D, D, D}; SchedDense S; S.init(NTOK, D, D, D, X.G, X.blk);
        EpiStore E{WSP(bf16_t, O_QX), D, LOG2E / sqrtf((float)XHD)}; RUN_GEMM(g, S, E); } break;
    case 7: if (EN(7)) ph_xattn_naive(p, l, c); break;
    case 8: if (EN(8)) { Gemm g{WSP(const bf16_t, O_MIXED), WSP(const bf16_t, O_XO_T) + (size_t)l * D * D, D, D, D}; SchedDense S; S.init(NTOK, D, D, D, X.G, X.blk);
        EpiResid E{p.k->out, p.k->out}; RUN_GEMM(g, S, E); } break;
    case 9: if (EN(9)) ph_ln<WVW>(p, p.k->in[I_LN2G] + l * D, p.k->in[I_LN2B] + l * D, 0, moe ? 1 : 0, p.k->in[I_ROUTER] + (size_t)(l / 2) * D * NEXP, X.gw, X.nw, X.lane); break;
    case 10: if (!EN(10)) break; if (!moe) { Gemm g{WSP(const bf16_t, O_XB), WSP(const bf16_t, O_FGU_T), D, D, D}; SchedDense S; S.init(NTOK, 2 * FF, D, D, X.G, X.blk); EpiSwiglu E{WSP(bf16_t, O_HID), FF}; RUN_GEMM(g, S, E); }
             else { ph_moe_weights(p, c); ph_moe_gather(p, c); } break;
    case 11: case 13:
        if (!EN(11)) break; if (!moe) { if (s == 11) { Gemm g{WSP(const bf16_t, O_HID), WSP(const bf16_t, O_FD_T), FF, FF, FF}; SchedDense S; S.init(NTOK, D, FF, FF, X.G, X.blk); EpiResid E{p.k->out, p.k->out}; RUN_GEMM(g, S, E); } }
        else { Gemm g{WSP(const bf16_t, O_XG), WSP(const bf16_t, O_MGU_T), D, D, D}; SchedMoe S; S.init(WSP(const unsigned, O_CTL), s == 11 ? 0 : 1, 0, X.G, X.blk);
               EpiSwiglu E{WSP(bf16_t, O_HIDM), FFE}; RUN_GEMM(g, S, E); } break;
    case 12: case 14: if (EN(12) && moe) { Gemm g{WSP(const bf16_t, O_HIDM), WSP(const bf16_t, O_MD_T), FFE, FFE, FFE}; SchedMoe S; S.init(WSP(const unsigned, O_CTL), s == 12 ? 0 : 1, 1, X.G, X.blk);
                 EpiStore E{WSP(bf16_t, O_XG), D, 1.0f}; RUN_GEMM(g, S, E); } break;
    case 15: if (EN(15)) ph_ln<WVW>(p, p.k->in[I_LN3G] + l * D, p.k->in[I_LN3B] + l * D, moe ? 1 : 0, 0, nullptr, X.gw, X.nw, X.lane); break;
    default: break;
    }
}

#ifndef CPU_TEST
namespace cg = cooperative_groups;
constexpr int LDS_BYTES = 147456;
__device__ __forceinline__ void run_step_fresh(int step) {
    KargPtr kp = (KargPtr)__builtin_amdgcn_kernarg_segment_ptr(); asm volatile("" : "+s"(kp));
    const PRef p{kp};
    extern __shared__ __attribute__((aligned(16))) unsigned char lds_raw[];
    int tid = threadIdx.x, blk = blockIdx.x, G = gridDim.x; asm volatile("" : "+v"(tid)); asm volatile("" : "+s"(blk)); asm volatile("" : "+s"(G));
    Exec X; const int wave = __builtin_amdgcn_readfirstlane(tid >> 6);
    X.G = G; X.blk = blk; X.tid = tid; X.lane = tid & 63; X.gw = wave * X.G + X.blk; X.nw = X.G * 8; X.c.gtid = X.gw * 64 + X.lane; X.c.gsz = X.nw * 64;
    X.lds = (LAS unsigned char*)lds_raw; X.lds_generic = lds_raw;
    run_step(p, step, X);
}
template <int STEP> __device__ __forceinline__ void prog(int lo, int hi, cg::grid_group& grid) {
    if constexpr (STEP < N_STEPS) {
        if constexpr (!step_is_empty(STEP)) { if (STEP >= lo && STEP < hi) { run_step_fresh(STEP); if (STEP + 1 < hi) grid.sync(); } }
        prog<STEP + 1>(lo, hi, grid);
    }
}
__global__ void __launch_bounds__(512, 2) mega(Params p) {
    cg::grid_group grid = cg::this_grid();
#ifdef ONLY_STEP
    run_step_fresh(ONLY_STEP); if (p.hi > 100) grid.sync();
#else
    prog<0>(p.lo, p.hi, grid);
#endif
}

extern "C" void kernel_launch(void* const* d_in, const int* in_sizes, int n_in, void* d_out, int out_size, void* d_ws, size_t ws_size, hipStream_t stream) {
    static int grid = 0;
    if (grid == 0) {
        if (n_in != N_IN || out_size != NTOK * D || ws_size < WS_TOTAL) { fprintf(stderr, "kernel_launch: unexpected problem (n_in %d, out %d, ws %zu < %zu)\n", n_in, out_size, ws_size, (size_t)WS_TOTAL); grid = -1; return; }
        int dev = 0, cus = 0, per_cu = 0;
        hipGetDevice(&dev); hipDeviceGetAttribute(&cus, hipDeviceAttributeMultiprocessorCount, dev);
        hipFuncSetAttribute((const void*)mega, hipFuncAttributeMaxDynamicSharedMemorySize, LDS_BYTES);
        hipOccupancyMaxActiveBlocksPerMultiprocessor(&per_cu, (const void*)mega, 512, LDS_BYTES);
        if (per_cu < 1) { fprintf(stderr, "kernel_launch: occupancy query says %d blocks per CU\n", per_cu); grid = -1; return; }
        grid = cus;
    }
    if (grid < 0) return;
    Params p{};
    for (int i = 0; i < N_IN; ++i) p.in[i] = (const float*)d_in[i];
    p.out = (float*)d_out; p.ws = (unsigned char*)d_ws;
#if defined(MULTI_LAUNCH)
    for (int s = 0; s < N_STEPS; ++s) { if (step_is_empty(s)) continue; p.lo = s; p.hi = s + 1; hipLaunchKernelGGL(mega, dim3(grid), dim3(512), LDS_BYTES, stream, p); }
#else
    p.lo = 0; p.hi = N_STEPS;
    void* args[] = {&p};
    hipError_t e = hipLaunchCooperativeKernel((const void*)mega, dim3(grid), dim3(512), args, LDS_BYTES, stream);
    if (e != hipSuccess) fprintf(stderr, "cooperative launch failed: %s (grid %d)\n", hipGetErrorString(e), grid);
#endif
}
#endif
```

```cpp
#ifndef CPU_TEST
#include <hip/hip_runtime.h>
#include <hip/hip_cooperative_groups.h>
#include <hip/hip_bf16.h>
#include <cstdio>
#include <cstdint>
#define DEV __device__ __forceinline__
#define HD __host__ __device__ __forceinline__
#else
#include <cstdio>
#include <cstdint>
#include <cstring>
#include <cmath>
#define DEV inline
#define HD inline
#endif

#ifndef CFG_D
#define CFG_D 1024
#define CFG_B 4
#define CFG_S 4096
#define CFG_MEM 256
#define CFG_FF 2816
#define CFG_FFE 3584
#endif
constexpr int D = CFG_D, NB = CFG_B, S = CFG_S, NTOK = NB * S, MEMT = CFG_MEM, FF = CFG_FF, FFE = CFG_FFE;
constexpr int XH = 4, XHD = D / XH, NMEM = NB * MEMT;
constexpr int DIN = 3480, DINP = 3584, MIXW = 1024;
constexpr int NEXP = 8;
constexpr int MOE_TMAX = 2 * NTOK / 256 + NEXP, MOE_THALF = (MOE_TMAX + 1) / 2, MOE_ROWS = MOE_TMAX * 256;
constexpr int C_AQKV = 0, C_AZ = 1152, C_ABETA = 1536, C_ADECAY = 1548, C_BQ = 1560, C_BK = 1944, C_BV = 2072, C_CF = 2200, C_CI = 2712, C_CQ = 2968, C_CG = 3224;
constexpr float DN_ALPHA = 1.41421356237309515f;
constexpr float LN_EPS = 1e-5f, RMS_EPS = 1e-6f;
constexpr float LOG2E = 1.4426950408889634f;

typedef unsigned short bf16_t;
typedef float f32x4 __attribute__((ext_vector_type(4)));
typedef unsigned u32x4 __attribute__((ext_vector_type(4)));
typedef unsigned u32x2 __attribute__((ext_vector_type(2)));

DEV float bf2f(bf16_t h) { unsigned u = (unsigned)h << 16; float f; __builtin_memcpy(&f, &u, 4); return f; }
DEV bf16_t f2bf(float f) { unsigned u; __builtin_memcpy(&u, &f, 4); return (bf16_t)((u + 0x7fffu + ((u >> 16) & 1u)) >> 16); }
DEV unsigned pk2(float lo, float hi) { return (unsigned)f2bf(lo) | ((unsigned)f2bf(hi) << 16); }
DEV float sigmoidf_(float x) { return 1.0f / (1.0f + expf(-x)); }
DEV float siluf_(float x) { return x / (1.0f + expf(-x)); }
DEV float softplusf_(float x) { return x > 20.f ? x : log1pf(expf(x)); }

enum { I_X = 0, I_MEM, I_WIN, I_CONVW, I_ALOG, I_DTB, I_GDNNW, I_QNW, I_KNW, I_LBL, I_HGNW, I_WOUT, I_LN1G, I_LN1B, I_XQ, I_XK, I_XV, I_XO,
       I_LN2G, I_LN2B, I_FWG, I_FWU, I_FWD, I_ROUTER, I_MWG, I_MWU, I_MWD, I_LN3G, I_LN3B, N_IN };
struct Params { const float* in[N_IN]; float* out; unsigned char* ws; int lo, hi; };
#ifdef CPU_TEST
typedef const Params* KargPtr;
#else
typedef const __attribute__((address_space(4))) Params* KargPtr;
#endif
struct PRef { KargPtr k; };

constexpr size_t al256(size_t x) { return (x + 255) & ~(size_t)255; }
constexpr size_t O_CTL = 0;
constexpr size_t O_LB = 4096;
constexpr size_t O_ROPE = O_LB + 2 * 256 * 4;
constexpr size_t O_TOPE = al256(O_ROPE + 64 * 16 * 2 * 4);
constexpr size_t O_TOPW = O_TOPE + (size_t)NTOK * 8;
constexpr size_t O_POSE = O_TOPW + (size_t)NTOK * 8;
constexpr size_t O_WIN_T = al256(O_POSE + (size_t)NTOK * 8);
constexpr size_t O_WOUT_T = O_WIN_T + (size_t)2 * DINP * D * 2;
constexpr size_t O_XQ_T = O_WOUT_T + (size_t)2 * D * MIXW * 2;
constexpr size_t O_XO_T = O_XQ_T + (size_t)2 * D * D * 2;
constexpr size_t O_XKV_T = O_XO_T + (size_t)2 * D * D * 2;
constexpr size_t O_FGU_T = O_XKV_T + (size_t)2 * 2 * D * D * 2;
constexpr size_t O_FD_T = O_FGU_T + (size_t)2 * FF * D * 2;
constexpr size_t O_MEMB = O_FD_T + (size_t)D * FF * 2;
constexpr size_t O_KMEM = O_MEMB + (size_t)NMEM * D * 2;
constexpr size_t O_VT = O_KMEM + (size_t)2 * NMEM * D * 2;
constexpr size_t O_XB = O_VT + (size_t)2 * NMEM * D * 2;
constexpr size_t O_R0 = al256(O_XB + (size_t)NTOK * D * 2);
constexpr size_t O_PROJ = O_R0;
constexpr size_t O_AQ = O_PROJ + (size_t)NTOK * DINP * 2;
constexpr size_t O_AK = O_AQ + (size_t)NTOK * 384 * 2;
constexpr size_t O_AV = O_AK + (size_t)NTOK * 384 * 2;
constexpr size_t O_QB = O_AV + (size_t)NTOK * 384 * 2;
constexpr size_t O_KB = O_QB + (size_t)NTOK * 384 * 2;
constexpr size_t O_KIN = O_KB + (size_t)NTOK * 128 * 2;
constexpr size_t O_CQ = O_KIN + (size_t)2 * NTOK * 256 * 2;
constexpr size_t O_MIXED = O_CQ + (size_t)NTOK * 256 * 2;
constexpr size_t O_BETA = O_MIXED + (size_t)NTOK * 1024 * 2;
constexpr size_t O_GG = O_BETA + (size_t)2 * NTOK * 6 * 4;
constexpr size_t SCAN_G = (size_t)2 * NB * 6 * (S / 64) * 8192, SCAN_H = (size_t)2 * NB * 4 * (S / 32) * 8192;
constexpr size_t O_GU = al256(O_GG + (size_t)2 * NTOK * 6 * 4);
constexpr size_t O_GW = O_GU + SCAN_G;
constexpr size_t O_GCS = O_GW + SCAN_G;
constexpr size_t O_GM = O_GCS + SCAN_G;
constexpr size_t O_HLS = O_GM + SCAN_G;
constexpr size_t O_HCD = O_HLS + SCAN_H;
constexpr size_t O_OC16 = O_HCD + SCAN_H / 32;
constexpr size_t O_OA16 = O_GM;
constexpr size_t O_QX = O_GU;
static_assert((size_t)2 * NTOK * 384 * 2 <= SCAN_G && (size_t)NTOK * D * 2 <= 2 * SCAN_G, "overlays");
constexpr size_t O_MIX_END = O_OC16 + (size_t)2 * NTOK * 256 * 2;
constexpr size_t O_HID = O_R0;
constexpr size_t O_MGU_T = O_R0;
constexpr size_t O_MD_T = O_MGU_T + (size_t)NEXP * 2 * FFE * D * 2;
constexpr size_t O_XG = O_MD_T + (size_t)NEXP * D * FFE * 2;
constexpr size_t O_HIDM = O_XG + (size_t)MOE_ROWS * D * 2;
constexpr size_t O_MOE_END = O_HIDM + (size_t)MOE_THALF * 256 * FFE * 2;
constexpr size_t WS_TOTAL = O_MIX_END > O_MOE_END ? O_MIX_END : O_MOE_END;
static_assert(O_HID + (size_t)NTOK * FF * 2 <= WS_TOTAL, "ws map");
struct Ctx { int gtid, gsz; };
#ifdef CPU_TEST
#define FENCE() do {} while (0)
#else
#define FENCE() asm volatile("" ::: "memory")
#endif
#define WSP(T, off) ((T*)(p.k->ws + (off)))

DEV void cvt_wt(const Ctx& c, const float* W, int K, int N, bf16_t* WT, int mode, int row_off) {
    const size_t items = (size_t)(K / 8) * N;
    for (size_t it = c.gtid; it < items; it += c.gsz) {
        const int n = (int)(it % N), k0 = (int)(it / N) * 8;
        const int row = mode == 0 ? row_off + n : (n >> 7) * 256 + (mode == 2 ? 128 : 0) + (n & 127);
        u32x4 o;
        o.x = pk2(W[(size_t)(k0 + 0) * N + n], W[(size_t)(k0 + 1) * N + n]); o.y = pk2(W[(size_t)(k0 + 2) * N + n], W[(size_t)(k0 + 3) * N + n]);
        o.z = pk2(W[(size_t)(k0 + 4) * N + n], W[(size_t)(k0 + 5) * N + n]); o.w = pk2(W[(size_t)(k0 + 6) * N + n], W[(size_t)(k0 + 7) * N + n]);
        *(u32x4*)(WT + (size_t)row * K + k0) = o;
    }
}
DEV void cvt_rows(const Ctx& c, const float* X, bf16_t* Y, size_t n) {
    for (size_t i = c.gtid; i < n / 4; i += c.gsz) { const f32x4 v = *(const f32x4*)(X + 4 * i); u32x2 o; o.x = pk2(v[0], v[1]); o.y = pk2(v[2], v[3]); *(u32x2*)(Y + 4 * i) = o; }
}
DEV void ph_prologue(const PRef p, const Ctx& c) {
    unsigned* ctl = WSP(unsigned, O_CTL);
    for (int i = c.gtid; i < 1024; i += c.gsz) ctl[i] = 0u;
    float* lb = WSP(float, O_LB);
    for (int i = c.gtid; i < 256; i += c.gsz) { const float l0 = p.k->in[I_LBL][i], l1 = p.k->in[I_LBL][256 + i]; lb[i] = 0.f; lb[256 + i] = 1.0f / (1.0f + expf(l0 - l1)); }
    float* rope = WSP(float, O_ROPE);
    for (int i = c.gtid; i < 64 * 16; i += c.gsz) { const int pos = i >> 4, f = i & 15; const float inv = exp2f(-(float)f * (13.287712379549449f / 16.0f)), a = (float)pos * inv;
        rope[2 * i] = cosf(a); rope[2 * i + 1] = sinf(a); }
    cvt_rows(c, p.k->in[I_X], WSP(bf16_t, O_XB), (size_t)NTOK * D);
    cvt_rows(c, p.k->in[I_MEM], WSP(bf16_t, O_MEMB), (size_t)NMEM * D);
    for (int l = 0; l < 2; ++l) {
        bf16_t* wi = WSP(bf16_t, O_WIN_T) + (size_t)l * DINP * D;
        cvt_wt(c, p.k->in[I_WIN] + (size_t)l * D * DIN, D, DIN, wi, 0, 0);
        for (size_t i = c.gtid; i < (size_t)(DINP - DIN) * D / 8; i += c.gsz) *(u32x4*)(wi + (size_t)DIN * D + 8 * i) = (u32x4){0u, 0u, 0u, 0u};
        cvt_wt(c, p.k->in[I_WOUT] + (size_t)l * MIXW * D, MIXW, D, WSP(bf16_t, O_WOUT_T) + (size_t)l * D * MIXW, 0, 0);
        cvt_wt(c, p.k->in[I_XQ] + (size_t)l * D * D, D, D, WSP(bf16_t, O_XQ_T) + (size_t)l * D * D, 0, 0);
        cvt_wt(c, p.k->in[I_XO] + (size_t)l * D * D, D, D, WSP(bf16_t, O_XO_T) + (size_t)l * D * D, 0, 0);
        cvt_wt(c, p.k->in[I_XK] + (size_t)l * D * D, D, D, WSP(bf16_t, O_XKV_T) + (size_t)l * 2 * D * D, 0, 0);
        cvt_wt(c, p.k->in[I_XV] + (size_t)l * D * D, D, D, WSP(bf16_t, O_XKV_T) + (size_t)l * 2 * D * D, 0, D);
    }
    cvt_wt(c, p.k->in[I_FWG], D, FF, WSP(bf16_t, O_FGU_T), 1, 0);
    cvt_wt(c, p.k->in[I_FWU], D, FF, WSP(bf16_t, O_FGU_T), 2, 0);
    cvt_wt(c, p.k->in[I_FWD], FF, D, WSP(bf16_t, O_FD_T), 0, 0);
}
DEV void ph_moe_weights(const PRef p, const Ctx& c) {
    for (int e = 0; e < NEXP; ++e) {
        cvt_wt(c, p.k->in[I_MWG] + (size_t)e * D * FFE, D, FFE, WSP(bf16_t, O_MGU_T) + (size_t)e * 2 * FFE * D, 1, 0);
        cvt_wt(c, p.k->in[I_MWU] + (size_t)e * D * FFE, D, FFE, WSP(bf16_t, O_MGU_T) + (size_t)e * 2 * FFE * D, 2, 0);
        cvt_wt(c, p.k->in[I_MWD] + (size_t)e * FFE * D, FFE, D, WSP(bf16_t, O_MD_T) + (size_t)e * D * FFE, 0, 0);
    }
}

DEV void conv8(const bf16_t* proj, const float* cw, int n, int t, int ch, float (&v)[8]) {
#pragma unroll
    for (int i = 0; i < 8; ++i) v[i] = 0.f;
#pragma unroll
    for (int j = 0; j < 5; ++j) { const int tt = t + j - 2;
        if (tt >= 0 && tt < S) { const u32x4 q = *(const u32x4*)(proj + (size_t)(n + j - 2) * DINP + C_AQKV + ch); const f32x4 w0 = *(const f32x4*)(cw + j * 1152 + ch), w1 = *(const f32x4*)(cw + j * 1152 + ch + 4);
            v[0] += bf2f((bf16_t)(q[0] & 0xffffu)) * w0[0]; v[1] += bf2f((bf16_t)(q[0] >> 16)) * w0[1]; v[2] += bf2f((bf16_t)(q[1] & 0xffffu)) * w0[2]; v[3] += bf2f((bf16_t)(q[1] >> 16)) * w0[3];
            v[4] += bf2f((bf16_t)(q[2] & 0xffffu)) * w1[0]; v[5] += bf2f((bf16_t)(q[2] >> 16)) * w1[1]; v[6] += bf2f((bf16_t)(q[3] & 0xffffu)) * w1[2]; v[7] += bf2f((bf16_t)(q[3] >> 16)) * w1[3]; } }
#pragma unroll
    for (int i = 0; i < 8; ++i) v[i] = siluf_(v[i]);
}
DEV void ph_prep(const PRef p, int l, const Ctx& c) {
    const bf16_t* proj = WSP(const bf16_t, O_PROJ);
#ifndef NO_PREP_A
    {
        const float* cw = p.k->in[I_CONVW] + (size_t)l * 5 * 1152;
        for (int it = c.gtid; it < NTOK * 18; it += c.gsz) {
            const int n = it / 18, r = it % 18, h = r % 6, part = r / 6, t = n % S, ch0 = part * 384 + h * 64;
            float sc = 1.f;
            if (part < 2) { float ss = 0.f;
                for (int i = 0; i < 64; i += 8) { float v[8]; conv8(proj, cw, n, t, ch0 + i, v);
#pragma unroll
                    for (int e = 0; e < 8; ++e) ss += v[e] * v[e]; }
                sc = 1.0f / sqrtf(ss + RMS_EPS); if (part == 0) sc *= 0.125f; }
            bf16_t* dst = (part == 0 ? WSP(bf16_t, O_AQ) : part == 1 ? WSP(bf16_t, O_AK) : WSP(bf16_t, O_AV)) + (size_t)n * 384 + h * 64;
            for (int i = 0; i < 64; i += 8) { float v[8]; conv8(proj, cw, n, t, ch0 + i, v);
                u32x4 o; o.x = pk2(v[0] * sc, v[1] * sc); o.y = pk2(v[2] * sc, v[3] * sc); o.z = pk2(v[4] * sc, v[5] * sc); o.w = pk2(v[6] * sc, v[7] * sc); *(u32x4*)(dst + i) = o; }
        }
        float* beta = WSP(float, O_BETA); float* gg = WSP(float, O_GG);
        for (int it = c.gtid; it < 2 * NTOK * 6; it += c.gsz) {
            const int dir = it / (NTOK * 6), r = it % (NTOK * 6), n = r / 6, h = r % 6;
            const float xb_ = bf2f(proj[(size_t)n * DINP + C_ABETA + dir * 6 + h]), xd = bf2f(proj[(size_t)n * DINP + C_ADECAY + dir * 6 + h]);
            beta[it] = sigmoidf_(xb_);
            gg[it] = -expf(p.k->in[I_ALOG][l * 12 + dir * 6 + h]) * softplusf_(xd + p.k->in[I_DTB][l * 12 + dir * 6 + h]);
        }
    }
#endif
#ifndef NO_PREP_B
    {
        const float* rope = WSP(const float, O_ROPE);
        for (int it = c.gtid; it < NTOK * 8; it += c.gsz) {
            const int n = it >> 3, j = it & 7, t = n % S;
            const bf16_t* src = proj + (size_t)n * DINP + (j < 6 ? C_BQ + j * 64 : C_BK + (j - 6) * 64);
            const float* nw = (j < 6 ? p.k->in[I_QNW] : p.k->in[I_KNW]) + l * 64;
            float ss = 0.f;
#pragma unroll
            for (int i = 0; i < 64; i += 8) { const u32x4 q = *(const u32x4*)(src + i);
#pragma unroll
                for (int e = 0; e < 4; ++e) { const float x0 = bf2f((bf16_t)(q[e] & 0xffffu)), x1 = bf2f((bf16_t)(q[e] >> 16)); ss += x0 * x0 + x1 * x1; } }
            const float rs = 1.0f / sqrtf(ss * (1.0f / 64.0f) + RMS_EPS) * ((j < 6) ? 0.125f * LOG2E : 1.0f);
            bf16_t* dst = j < 6 ? WSP(bf16_t, O_QB) + (size_t)n * 384 + j * 64 : WSP(bf16_t, O_KB) + (size_t)n * 128 + (j - 6) * 64;
            for (int a = 0; a < 2; ++a) { const int pos = a == 0 ? t / 64 : t % 64; float v[32];
#pragma unroll
                for (int i = 0; i < 32; i += 8) { const u32x4 q = *(const u32x4*)(src + a * 32 + i); const f32x4 w0 = *(const f32x4*)(nw + a * 32 + i), w1 = *(const f32x4*)(nw + a * 32 + i + 4);
                    v[i] = bf2f((bf16_t)(q[0] & 0xffffu)) * w0[0]; v[i + 1] = bf2f((bf16_t)(q[0] >> 16)) * w0[1]; v[i + 2] = bf2f((bf16_t)(q[1] & 0xffffu)) * w0[2]; v[i + 3] = bf2f((bf16_t)(q[1] >> 16)) * w0[3];
                    v[i + 4] = bf2f((bf16_t)(q[2] & 0xffffu)) * w1[0]; v[i + 5] = bf2f((bf16_t)(q[2] >> 16)) * w1[1]; v[i + 6] = bf2f((bf16_t)(q[3] & 0xffffu)) * w1[2]; v[i + 7] = bf2f((bf16_t)(q[3] >> 16)) * w1[3]; }
#pragma unroll
                for (int i = 0; i < 16; ++i) { const float cs = rope[(pos * 16 + i) * 2] * rs, sn = rope[(pos * 16 + i) * 2 + 1] * rs; const float x1 = v[i], x2 = v[16 + i];
                    v[i] = x1 * cs - x2 * sn; v[16 + i] = x2 * cs + x1 * sn; }
#pragma unroll
                for (int i = 0; i < 32; i += 8) { u32x4 w; w.x = pk2(v[i], v[i + 1]); w.y = pk2(v[i + 2], v[i + 3]); w.z = pk2(v[i + 4], v[i + 5]); w.w = pk2(v[i + 6], v[i + 7]); *(u32x4*)(dst + a * 32 + i) = w; } }
        }
    }
#endif
#ifndef NO_PREP_C
    {
        const float* lb = WSP(const float, O_LB) + l * 256; bf16_t* kin = WSP(bf16_t, O_KIN); bf16_t* cq = WSP(bf16_t, O_CQ);
        for (int it = c.gtid; it < NTOK * 256; it += c.gsz) {
            const int n = it >> 8, ch = it & 255; const bf16_t* row = proj + (size_t)n * DINP;
            const float om = 1.0f - lb[ch];
            kin[(size_t)n * 256 + ch] = f2bf(fminf(om * sigmoidf_(-bf2f(row[C_CF + ch])), 0.99609375f));
            kin[(size_t)(NTOK + n) * 256 + ch] = f2bf(fminf(om * sigmoidf_(-bf2f(row[C_CF + 256 + ch])), 0.99609375f));
            cq[it] = f2bf(siluf_(bf2f(row[C_CQ + ch])) * 0.125f);
        }
    }
#endif
}

DEV void ph_attn_naive(const PRef p, const Ctx& c) {
    const bf16_t* Q = WSP(const bf16_t, O_QB); const bf16_t* Kb = WSP(const bf16_t, O_KB); const bf16_t* proj = WSP(const bf16_t, O_PROJ); bf16_t* mixed = WSP(bf16_t, O_MIXED);
    for (int it = c.gtid; it < NB * 6 * S; it += c.gsz) {
        const int t = it % S, hq = (it / S) % 6, b = it / (6 * S), kv = hq / 3, n = b * S + t;
        float q[64], acc[64];
#pragma unroll
        for (int i = 0; i < 64; ++i) { q[i] = bf2f(Q[(size_t)n * 384 + hq * 64 + i]); acc[i] = 0.f; }
        float m = -1e30f, lsum = 0.f;
        for (int s2 = 0; s2 < S; ++s2) {
            const bf16_t* kr = Kb + (size_t)(b * S + s2) * 128 + kv * 64; const bf16_t* vr = proj + (size_t)(b * S + s2) * DINP + C_BV + kv * 64;
            float sc = 0.f;
#pragma unroll
            for (int i = 0; i < 64; ++i) sc += q[i] * bf2f(kr[i]);
            FENCE();
            if (sc > m) { const float f = exp2f(m - sc); lsum *= f;
#pragma unroll
                for (int i = 0; i < 64; ++i) acc[i] *= f;
                m = sc; }
            const float pe = exp2f(sc - m); lsum += pe;
#pragma unroll
            for (int i = 0; i < 64; ++i) acc[i] += pe * bf2f(vr[i]);
        }
        const float inv = 1.0f / lsum;
#pragma unroll
        for (int i = 0; i < 64; ++i) mixed[(size_t)n * 1024 + 384 + hq * 64 + i] = f2bf(acc[i] * inv);
    }
}
DEV void ph_gdn_naive(const PRef p, const Ctx& c) {
    const bf16_t* AQ = WSP(const bf16_t, O_AQ); const bf16_t* AK = WSP(const bf16_t, O_AK); const bf16_t* AV = WSP(const bf16_t, O_AV);
    const float* beta = WSP(const float, O_BETA); const float* gg = WSP(const float, O_GG); bf16_t* OA = WSP(bf16_t, O_OA16);
    for (int it = c.gtid; it < 2 * NB * 6 * 64; it += c.gsz) {
        const int e = it & 63, h = (it >> 6) % 6, b = (it / 384) % NB, dir = it / (384 * NB);
        float st[64];
#pragma unroll
        for (int i = 0; i < 64; ++i) st[i] = 0.f;
        for (int s2 = 0; s2 < S; ++s2) {
            const int t = dir == 0 ? s2 : S - 1 - s2, n = b * S + t;
            const float a = expf(gg[((size_t)dir * NTOK + n) * 6 + h]), be = beta[((size_t)dir * NTOK + n) * 6 + h];
            const bf16_t* kr = AK + (size_t)n * 384 + h * 64; const bf16_t* qr = AQ + (size_t)n * 384 + h * 64;
            float kk[64]; float pr = 0.f;
#pragma unroll
            for (int i = 0; i < 64; ++i) { kk[i] = bf2f(kr[i]); pr += kk[i] * st[i]; }
            const float vn = be * (bf2f(AV[(size_t)n * 384 + h * 64 + e]) - a * pr);
            float o = 0.f;
#pragma unroll
            for (int i = 0; i < 64; ++i) { st[i] = a * st[i] + kk[i] * vn; o += st[i] * bf2f(qr[i]); }
            OA[((size_t)dir * NTOK + n) * 384 + h * 64 + e] = f2bf(o);
        }
    }
}
DEV void ph_hgrn_naive(const PRef p, const Ctx& c) {
    const bf16_t* KIN = WSP(const bf16_t, O_KIN); const bf16_t* CQ = WSP(const bf16_t, O_CQ); const bf16_t* proj = WSP(const bf16_t, O_PROJ); bf16_t* OC = WSP(bf16_t, O_OC16);
    for (int it = c.gtid; it < 2 * NB * 4 * 64; it += c.gsz) {
        const int e = it & 63, h = (it >> 6) % 4, b = (it / 256) % NB, dir = it / (256 * NB);
        float st[64];
#pragma unroll
        for (int i = 0; i < 64; ++i) st[i] = 0.f;
        for (int s2 = 0; s2 < S; ++s2) {
            const int t = dir == 0 ? s2 : S - 1 - s2, n = b * S + t;
            const bf16_t* kr = KIN + ((size_t)dir * NTOK + n) * 256 + h * 64; const bf16_t* qr = CQ + (size_t)n * 256 + h * 64;
            const float v = bf2f(proj[(size_t)n * DINP + C_CI + h * 64 + e]);
            float o = 0.f;
#pragma unroll
            for (int i = 0; i < 64; ++i) { const float k = bf2f(kr[i]); st[i] = (1.0f - k) * st[i] + k * v; o += st[i] * bf2f(qr[i]); }
            OC[((size_t)dir * NTOK + n) * 256 + h * 64 + e] = f2bf(o);
        }
    }
}
DEV void ph_combine(const PRef p, int l, const Ctx& c) {
    const bf16_t* proj = WSP(const bf16_t, O_PROJ); const bf16_t* OA = WSP(const bf16_t, O_OA16); const bf16_t* OC = WSP(const bf16_t, O_OC16); bf16_t* mixed = WSP(bf16_t, O_MIXED);
    for (int it = c.gtid; it < NTOK * 10; it += c.gsz) {
        const int n = it / 10, j = it % 10; const bool isA = j < 6; const int h = isA ? j : j - 6;
        const bf16_t* s0 = isA ? OA + (size_t)n * 384 + h * 64 : OC + (size_t)n * 256 + h * 64;
        const bf16_t* s1 = isA ? s0 + (size_t)NTOK * 384 : s0 + (size_t)NTOK * 256;
        const float* nw = (isA ? p.k->in[I_GDNNW] : p.k->in[I_HGNW]) + l * 64;
        const bf16_t* gate = proj + (size_t)n * DINP + (isA ? C_AZ : C_CG) + h * 64;
        float v[64]; float ss = 0.f;
#pragma unroll
        for (int i = 0; i < 64; i += 8) { const u32x4 a = *(const u32x4*)(s0 + i), b2 = *(const u32x4*)(s1 + i);
#pragma unroll
            for (int e = 0; e < 4; ++e) { v[i + 2 * e] = bf2f((bf16_t)(a[e] & 0xffffu)) + bf2f((bf16_t)(b2[e] & 0xffffu)); v[i + 2 * e + 1] = bf2f((bf16_t)(a[e] >> 16)) + bf2f((bf16_t)(b2[e] >> 16));
                ss += v[i + 2 * e] * v[i + 2 * e] + v[i + 2 * e + 1] * v[i + 2 * e + 1]; } }
        const float rs = 1.0f / sqrtf(ss * (1.0f / 64.0f) + RMS_EPS);
        bf16_t* dst = mixed + (size_t)n * 1024 + (isA ? 0 : 768) + h * 64;
#pragma unroll
        for (int i = 0; i < 64; i += 2) { const float g0 = bf2f(gate[i]), g1 = bf2f(gate[i + 1]);
            const float a0 = isA ? siluf_(g0) : sigmoidf_(g0), a1 = isA ? siluf_(g1) : sigmoidf_(g1);
            *(unsigned*)(dst + i) = pk2(v[i] * rs * nw[i] * a0, v[i + 1] * rs * nw[i + 1] * a1); }
    }
}
DEV void ph_xattn_naive(const PRef p, int l, const Ctx& c) {
    const bf16_t* QX = WSP(const bf16_t, O_QX); const bf16_t* KM = WSP(const bf16_t, O_KMEM) + (size_t)l * NMEM * D; const bf16_t* VT = WSP(const bf16_t, O_VT) + (size_t)l * NMEM * D;
    bf16_t* OX = WSP(bf16_t, O_MIXED);
    constexpr int QW = XHD / 4;
    for (int it = c.gtid; it < NTOK * XH * 4; it += c.gsz) {
        const int part = it & 3, h = (it >> 2) % XH, n = it / (4 * XH), b = n / S;
        const bf16_t* qr = QX + (size_t)n * D + h * XHD;
        float acc[QW];
#pragma unroll
        for (int i = 0; i < QW; ++i) acc[i] = 0.f;
        float m = -1e30f, lsum = 0.f;
        for (int k = 0; k < MEMT; ++k) {
            const bf16_t* kr = KM + (size_t)(b * MEMT + k) * D + h * XHD;
            float sc = 0.f;
            for (int i = 0; i < XHD; ++i) sc += bf2f(qr[i]) * bf2f(kr[i]);
            if (sc > m) { const float f = exp2f(m - sc); lsum *= f;
#pragma unroll
                for (int i = 0; i < QW; ++i) acc[i] *= f;
                m = sc; }
            const float pe = exp2f(sc - m); lsum += pe;
#pragma unroll
            for (int i = 0; i < QW; ++i) acc[i] += pe * bf2f(VT[((size_t)b * D + h * XHD + part * QW + i) * MEMT + k]);
        }
        const float inv = 1.0f / lsum;
#pragma unroll
        for (int i = 0; i < QW; ++i) OX[(size_t)n * D + h * XHD + part * QW + i] = f2bf(acc[i] * inv);
    }
}

template <int WV> struct WaveOps;
template <> struct WaveOps<1> { static DEV float sum(float v) { return v; } };
#ifndef CPU_TEST
template <> struct WaveOps<64> { static DEV float sum(float v) {
#pragma unroll
    for (int o = 1; o < 64; o <<= 1) v += __shfl_xor(v, o);
    return v; } };
#endif
template <int WV> DEV void ph_ln(const PRef p, const float* g, const float* bta, int mode, int route, const float* wr, int gw, int nw, int lane) {
    constexpr int PER = D / WV / 4;
    float* XF = p.k->out; bf16_t* XB = WSP(bf16_t, O_XB);
    const int* tope_r = WSP(const int, O_TOPE); const float* topw_r = WSP(const float, O_TOPW); const int* pose_r = WSP(const int, O_POSE); const unsigned* cnt = WSP(const unsigned, O_CTL);
    int pstart[NEXP];
    if (mode == 1) { int acc = 0;
#pragma unroll
        for (int e = 0; e < NEXP; ++e) { pstart[e] = acc; acc += (int)((cnt[e] + 255u) >> 8) * 256; } }
    for (int row = gw; row < NTOK; row += nw) {
        f32x4 v[PER]; float s = 0.f;
        float* xr = XF + (size_t)row * D;
#pragma unroll
        for (int j = 0; j < PER; ++j) v[j] = *(const f32x4*)(xr + (j * WV + lane) * 4);
        if (mode == 1) {
            const int e0 = tope_r[row * 2], e1 = tope_r[row * 2 + 1]; const float w0 = topw_r[row * 2], w1 = topw_r[row * 2 + 1];
            int r0 = 0, r1 = 0;
#pragma unroll
            for (int e = 0; e < NEXP; ++e) { if (e == e0) r0 = pstart[e]; if (e == e1) r1 = pstart[e]; }
            r0 += pose_r[row * 2]; r1 += pose_r[row * 2 + 1];
            const bf16_t* y0 = WSP(const bf16_t, O_XG) + (size_t)r0 * D; const bf16_t* y1 = WSP(const bf16_t, O_XG) + (size_t)r1 * D;
#pragma unroll
            for (int j = 0; j < PER; ++j) { const u32x2 a = *(const u32x2*)(y0 + (j * WV + lane) * 4), b2 = *(const u32x2*)(y1 + (j * WV + lane) * 4);
                v[j][0] = DN_ALPHA * v[j][0] + w0 * bf2f((bf16_t)(a.x & 0xffffu)) + w1 * bf2f((bf16_t)(b2.x & 0xffffu));
                v[j][1] = DN_ALPHA * v[j][1] + w0 * bf2f((bf16_t)(a.x >> 16)) + w1 * bf2f((bf16_t)(b2.x >> 16));
                v[j][2] = DN_ALPHA * v[j][2] + w0 * bf2f((bf16_t)(a.y & 0xffffu)) + w1 * bf2f((bf16_t)(b2.y & 0xffffu));
                v[j][3] = DN_ALPHA * v[j][3] + w0 * bf2f((bf16_t)(a.y >> 16)) + w1 * bf2f((bf16_t)(b2.y >> 16)); }
        }
#pragma unroll
        for (int j = 0; j < PER; ++j) s += (v[j][0] + v[j][1]) + (v[j][2] + v[j][3]);
        const float mean = WaveOps<WV>::sum(s) * (1.0f / D); float s2 = 0.f;
#pragma unroll
        for (int j = 0; j < PER; ++j) { v[j] = v[j] - mean; s2 += (v[j][0] * v[j][0] + v[j][1] * v[j][1]) + (v[j][2] * v[j][2] + v[j][3] * v[j][3]); }
        const float rstd = 1.0f / sqrtf(WaveOps<WV>::sum(s2) * (1.0f / D) + LN_EPS);
        float lg[NEXP];
#pragma unroll
        for (int e = 0; e < NEXP; ++e) lg[e] = 0.f;
#pragma unroll
        for (int j = 0; j < PER; ++j) { const int c0 = (j * WV + lane) * 4; const f32x4 gv = *(const f32x4*)(g + c0), bv = *(const f32x4*)(bta + c0);
            f32x4 o = v[j] * rstd * gv + bv; *(f32x4*)(xr + c0) = o; u32x2 w; w.x = pk2(o[0], o[1]); w.y = pk2(o[2], o[3]); *(u32x2*)(XB + (size_t)row * D + c0) = w;
            if (route) {
#pragma unroll
                for (int q = 0; q < 4; ++q) { const f32x4 r0 = *(const f32x4*)(wr + (size_t)(c0 + q) * NEXP), r1 = *(const f32x4*)(wr + (size_t)(c0 + q) * NEXP + 4);
                    lg[0] += o[q] * r0[0]; lg[1] += o[q] * r0[1]; lg[2] += o[q] * r0[2]; lg[3] += o[q] * r0[3]; lg[4] += o[q] * r1[0]; lg[5] += o[q] * r1[1]; lg[6] += o[q] * r1[2]; lg[7] += o[q] * r1[3]; } } }
        if (route) {
#pragma unroll
            for (int e = 0; e < NEXP; ++e) lg[e] = WaveOps<WV>::sum(lg[e]);
            if (lane == 0) {
                int e0 = 0; float m0 = lg[0];
#pragma unroll
                for (int e = 1; e < NEXP; ++e) if (lg[e] > m0) { m0 = lg[e]; e0 = e; }
                int e1 = -1; float m1 = -3e38f;
#pragma unroll
                for (int e = 0; e < NEXP; ++e) if (e != e0 && lg[e] > m1) { m1 = lg[e]; e1 = e; }
                if (e1 < 0) { e1 = (e0 + 1) & (NEXP - 1); m1 = m0; }
                const float w1 = 1.0f / (1.0f + expf(m0 - m1)), w0 = 1.0f - w1;
                int* tope = WSP(int, O_TOPE); float* topw = WSP(float, O_TOPW); int* pose = WSP(int, O_POSE); unsigned* cw = WSP(unsigned, O_CTL);
                tope[row * 2] = e0; tope[row * 2 + 1] = e1; topw[row * 2] = w0; topw[row * 2 + 1] = w1;
#ifndef CPU_TEST
                pose[row * 2] = (int)atomicAdd(cw + e0, 1u); pose[row * 2 + 1] = (int)atomicAdd(cw + e1, 1u);
#else
                pose[row * 2] = (int)cw[e0]++; pose[row * 2 + 1] = (int)cw[e1]++;
#endif
            }
        }
    }
}
DEV void ph_moe_gather(const PRef p, const Ctx& c) {
    const unsigned* cnt = WSP(const unsigned, O_CTL); const int* tope = WSP(const int, O_TOPE); const int* pose = WSP(const int, O_POSE);
    const bf16_t* XB = WSP(const bf16_t, O_XB); bf16_t* XG = WSP(bf16_t, O_XG);
    int pstart[NEXP]; { int acc = 0;
#pragma unroll
        for (int e = 0; e < NEXP; ++e) { pstart[e] = acc; acc += (int)((cnt[e] + 255u) >> 8) * 256; } }
    constexpr int CH = D / 8;
    for (size_t it = c.gtid; it < (size_t)NTOK * 2 * CH; it += c.gsz) {
        const int ch = (int)(it % CH), tk = (int)(it / CH), e = tope[tk];
        int r = 0;
#pragma unroll
        for (int q = 0; q < NEXP; ++q) if (q == e) r = pstart[q];
        r += pose[tk];
        *(u32x4*)(XG + (size_t)r * D + ch * 8) = *(const u32x4*)(XB + (size_t)(tk >> 1) * D + ch * 8);
    }
}
struct Unit { int pm, pn, aux; long aoff, boff; };
struct Gemm { const bf16_t* A; const bf16_t* Bt; int lda, ldb, K; };
constexpr int NXCD = 8, WGM = 8;

struct SchedDense {
    int nM, nN, nwg, G, c, lda, ldb;
    HD void init(int M, int N, int lda_, int ldb_, int G_, int c_) { nM = M / 256; nN = N / 256; nwg = nM * nN; G = G_; c = c_; lda = lda_; ldb = ldb_; }
    HD bool next(int i, Unit& u) const {
        const long L = (long)i * G + c; if (L >= nwg) return false;
        int wgid = (int)L; { const int q = nwg / NXCD, r = nwg % NXCD, xcd = wgid % NXCD, off = wgid / NXCD; wgid = (xcd < r ? xcd * (q + 1) : r * (q + 1) + (xcd - r) * q) + off; }
        const int nig = WGM * nN, gid = wgid / nig, fm = gid * WGM, gsz = (nM - fm) < WGM ? (nM - fm) : WGM;
        u.pm = fm + ((wgid % nig) % gsz); u.pn = (wgid % nig) / gsz; u.aux = u.pm;
        u.aoff = (long)u.pm * 256 * lda * 2; u.boff = (long)u.pn * 256 * ldb * 2; return true;
    }
};
struct SchedKV {
    int G, c;
    HD void init(int G_, int c_) { G = G_; c = c_; }
    HD bool next(int i, Unit& u) const {
        constexpr int nM = NMEM / 256, nN = 2 * D / 256;
        const int L = i * G + c; if (L >= 2 * nM * nN) return false;
        u.aux = L / (nM * nN); u.pm = (L % (nM * nN)) / nN; u.pn = L % nN;
        u.aoff = (long)u.pm * 256 * D * 2; u.boff = ((long)u.aux * 2 * D + u.pn * 256) * D * 2; return true;
    }
};
struct SchedMoe {
    int G, c, t0, t1, nN, which; int tend[NEXP];
    HD void init(const unsigned* cnt, int half, int which_, int G_, int c_) {
        G = G_; c = c_; which = which_; int acc = 0;
        for (int e = 0; e < NEXP; ++e) { acc += (int)((cnt[e] + 255u) >> 8); tend[e] = acc; }
        const int th = (acc + 1) / 2; t0 = half == 0 ? 0 : th; t1 = half == 0 ? th : acc;
        nN = which == 0 ? 2 * FFE / 256 : D / 256;
    }
    HD bool next(int i, Unit& u) const {
        const long L = (long)i * G + c; if (L >= (long)(t1 - t0) * nN) return false;
        const int t = t0 + (int)(L / nN); u.pn = (int)(L % nN); u.pm = t; u.aux = t - t0;
        int e = 0;
        for (int q = 0; q < NEXP - 1; ++q) e += (t >= tend[q]) ? 1 : 0;
        if (which == 0) { u.aoff = (long)t * 256 * D * 2; u.boff = ((long)e * 2 * FFE + u.pn * 256) * D * 2; }
        else { u.aoff = (long)u.aux * 256 * FFE * 2; u.boff = ((long)e * D + u.pn * 256) * FFE * 2; }
        return true;
    }
};

struct EpiStore {
    static constexpr bool PAIR = false; bf16_t* O; int ldc; float scale;
    DEV void apply(const Unit& u, int r, int c, f32x4 v) const { u32x2 w; w.x = pk2(v[0] * scale, v[1] * scale); w.y = pk2(v[2] * scale, v[3] * scale);
        *(u32x2*)(O + (size_t)(u.pm * 256 + r) * ldc + u.pn * 256 + c) = w; }
};
struct EpiResid {
    static constexpr bool PAIR = false; const float* src; float* dst;
    DEV void apply(const Unit& u, int r, int c, f32x4 v) const { const size_t o = (size_t)(u.pm * 256 + r) * D + u.pn * 256 + c; const f32x4 s = *(const f32x4*)(src + o); *(f32x4*)(dst + o) = s * DN_ALPHA + v; }
};
struct EpiKV {
    static constexpr bool PAIR = false; bf16_t* KM; bf16_t* VT;
    DEV void apply(const Unit& u, int r, int c, f32x4 v) const { const int row = u.pm * 256 + r, col = u.pn * 256 + c;
        if (col < D) { u32x2 w; w.x = pk2(v[0], v[1]); w.y = pk2(v[2], v[3]); *(u32x2*)(KM + ((size_t)u.aux * NMEM + row) * D + col) = w; }
        else { const int b = row / MEMT, key = row % MEMT; bf16_t* o = VT + (((size_t)u.aux * NB + b) * D + (col - D)) * MEMT + key;
            o[0] = f2bf(v[0]); o[MEMT] = f2bf(v[1]); o[2 * MEMT] = f2bf(v[2]); o[3 * MEMT] = f2bf(v[3]); } }
};
struct EpiSwiglu {
    static constexpr bool PAIR = true; bf16_t* H; int ldh;
    DEV void apply2(const Unit& u, int r, int c, f32x4 g, f32x4 up) const { u32x2 w; w.x = pk2(siluf_(g[0]) * up[0], siluf_(g[1]) * up[1]); w.y = pk2(siluf_(g[2]) * up[2], siluf_(g[3]) * up[3]);
        *(u32x2*)(H + (size_t)(u.aux * 256 + r) * ldh + u.pn * 128 + c) = w; }
};

#ifdef CPU_TEST
template <class Sched, class Epi> static void gemm_cpu(const Gemm& g, Sched S_, const Epi& E, int G) {
    float* tile = new float[256 * 256];
    for (int c = 0; c < G; ++c) { Sched S2 = S_; S2.c = c; S2.G = G; Unit u;
        for (int i = 0; S2.next(i, u); ++i) {
            const bf16_t* A = (const bf16_t*)((const char*)g.A + u.aoff); const bf16_t* B = (const bf16_t*)((const char*)g.Bt + u.boff);
            for (int r = 0; r < 256; ++r) for (int cc = 0; cc < 256; ++cc) { float a = 0.f; for (int k = 0; k < g.K; ++k) a += bf2f(A[(size_t)r * g.lda + k]) * bf2f(B[(size_t)cc * g.ldb + k]); tile[r * 256 + cc] = a; }
            for (int r = 0; r < 256; ++r) {
                if constexpr (Epi::PAIR) { for (int cc = 0; cc < 128; cc += 4) E.apply2(u, r, cc, *(f32x4*)(tile + r * 256 + cc), *(f32x4*)(tile + r * 256 + 128 + cc)); }
                else { for (int cc = 0; cc < 256; cc += 4) E.apply(u, r, cc, *(f32x4*)(tile + r * 256 + cc)); } } } }
    delete[] tile;
}
#endif
#ifndef CPU_TEST
#define LAS __attribute__((address_space(3)))
typedef short bf16x8 __attribute__((ext_vector_type(8)));
constexpr int BK = 64, HALF = 128, HTB = HALF * BK * 2;
__host__ __device__ __forceinline__ int lds_byte(int r, int c) { const int st = (r >> 4) * 2 + (c >> 5), rr = r & 15, cc = c & 31, ob = rr * 64 + cc * 2; return st * 1024 + (ob ^ (((ob >> 9) & 1) << 5)); }
__host__ __device__ __forceinline__ void stage_rc(int b, int& R, int& C) { const int st = b / 1024, sb = b % 1024, swz = sb ^ (((sb >> 9) & 1) << 5); R = (st >> 1) * 16 + swz / 64; C = (st & 1) * 32 + (swz % 64) / 2; }

template <class Epi> __device__ __forceinline__ void run_epi(const Epi& E, const f32x4 (&acc)[2][2][4][2], const Unit& u, int wr, int wc, int fr, int fq) {
#pragma unroll
    for (int ai = 0; ai < 2; ++ai)
#pragma unroll
        for (int m = 0; m < 4; ++m) { const int r = ai * HALF + wr * 64 + m * 16 + fr;
            if constexpr (Epi::PAIR) {
#pragma unroll
                for (int n = 0; n < 2; ++n) E.apply2(u, r, wc * 32 + n * 16 + 4 * fq, acc[ai][0][m][n], acc[ai][1][m][n]);
                asm volatile("" ::: "memory");
            } else {
#pragma unroll
                for (int bj = 0; bj < 2; ++bj)
#pragma unroll
                    for (int n = 0; n < 2; ++n) E.apply(u, r, bj * HALF + wc * 32 + n * 16 + 4 * fq, acc[ai][bj][m][n]);
                asm volatile("" ::: "memory");
            } }
}

template <class Epi, class Sched>
__device__ __forceinline__ void gemm_phase(LAS unsigned char* lds, const int tid  , const Gemm g, const Sched& S, const Epi& E) {
    const int wid = __builtin_amdgcn_readfirstlane(tid >> 6), lane = tid & 63, wr = wid >> 2, wc = wid & 3, fr = lane & 15, fq = lane >> 4;
    const int K = g.K, nt = K / BK;
    unsigned voffA[2], voffB[2];
#pragma unroll
    for (int i = 0; i < 2; ++i) { int R, C; stage_rc(tid * 16 + i * 8192, R, C); voffA[i] = (unsigned)(R * g.lda + C) * 2u; voffB[i] = (unsigned)(R * g.ldb + C) * 2u; }
    const size_t kstep = (size_t)(BK * 2);
    const size_t hstepA = (size_t)HALF * g.lda * 2, hstepB = (size_t)HALF * g.ldb * 2;
    const unsigned ldsw = (unsigned)wid * 1024u;
    const int aoff = lds_byte(wr * 64 + fr, fq * 8), boff = lds_byte(wc * 32 + fr, fq * 8);
#define PG8_SA(b, h) (((b) * 2 + (h)) * HTB)
#define PG8_SB(b, h) ((4 + (b) * 2 + (h)) * HTB)
#define PG8_STAGE(bufoff, gbase, voff) do { _Pragma("unroll") for (int _i = 0; _i < 2; ++_i) \
        __builtin_amdgcn_global_load_lds((const unsigned*)((const char*)(gbase) + (voff)[_i]), (LAS unsigned*)(lds + (bufoff) + ldsw + _i * 8192), 16, 0, 0); } while (0)
#define PG8_LDA(dst, b, h) do { _Pragma("unroll") for (int m = 0; m < 4; ++m) _Pragma("unroll") for (int k = 0; k < 2; ++k) dst[m][k] = *(const LAS bf16x8*)(lds + PG8_SA(b, h) + aoff + m * 2048 + k * 1024); } while (0)
#define PG8_LDB(dst, b, h) do { _Pragma("unroll") for (int n = 0; n < 2; ++n) _Pragma("unroll") for (int k = 0; k < 2; ++k) dst[n][k] = *(const LAS bf16x8*)(lds + PG8_SB(b, h) + boff + n * 2048 + k * 1024); } while (0)
#define PG8_MMA(ai, bj, At, Bt) do { __builtin_amdgcn_s_setprio(1); _Pragma("unroll") for (int m = 0; m < 4; ++m) _Pragma("unroll") for (int n = 0; n < 2; ++n) _Pragma("unroll") for (int k = 0; k < 2; ++k) \
        acc[ai][bj][m][n] = __builtin_amdgcn_mfma_f32_16x16x32_bf16(Bt[n][k], At[m][k], acc[ai][bj][m][n], 0, 0, 0); __builtin_amdgcn_s_setprio(0); } while (0)
#define PG8_WAIT_V(n) asm volatile("s_waitcnt vmcnt(" #n ")" ::: "memory")
#define PG8_WAIT_L(n) asm volatile("s_waitcnt lgkmcnt(" #n ")" ::: "memory")
#define PG8_BAR __builtin_amdgcn_s_barrier()
#define PG8_SCHED __builtin_amdgcn_sched_barrier(0)
    Unit cur, nxt; int ui = 0;
    if (!S.next(0, cur)) return;
    f32x4 acc[2][2][4][2];
#pragma unroll
    for (int a = 0; a < 2; ++a)
#pragma unroll
        for (int b = 0; b < 2; ++b)
#pragma unroll
            for (int m = 0; m < 4; ++m)
#pragma unroll
                for (int n = 0; n < 2; ++n) acc[a][b][m][n] = (f32x4){0.f, 0.f, 0.f, 0.f};
    bf16x8 At[4][2], B0[2][2], B1[2][2];
    const char* cA = (const char*)g.A + cur.aoff; const char* cB = (const char*)g.Bt + cur.boff;
    PG8_STAGE(PG8_SB(0, 0), cB, voffB); PG8_STAGE(PG8_SB(0, 1), cB + hstepB, voffB); PG8_STAGE(PG8_SA(0, 0), cA, voffA); PG8_STAGE(PG8_SA(0, 1), cA + hstepA, voffA);
    if (wr == 1) PG8_BAR;
    PG8_WAIT_V(2); PG8_BAR;
    PG8_STAGE(PG8_SB(1, 0), cB + kstep, voffB); PG8_STAGE(PG8_SA(1, 0), cA + kstep, voffA); PG8_STAGE(PG8_SB(1, 1), cB + hstepB + kstep, voffB);
    PG8_WAIT_V(6); PG8_BAR;
    for (;;) {
        const bool has_next = S.next(ui + 1, nxt);
        const char* nA = has_next ? (const char*)g.A + nxt.aoff : cA; const char* nB = has_next ? (const char*)g.Bt + nxt.boff : cB;
        for (int t = 0; t < nt; t += 2) {
            const bool last = (t == nt - 2);
            const char* a1 = cA + (size_t)(t + 1) * kstep;
            const char* a2 = last ? nA : cA + (size_t)(t + 2) * kstep; const char* b2 = last ? nB : cB + (size_t)(t + 2) * kstep;
            const char* a3 = a2 + kstep; const char* b3 = b2 + kstep;
            PG8_LDB(B0, 0, 0); PG8_LDB(B1, 0, 1); PG8_SCHED; PG8_LDA(At, 0, 0); PG8_STAGE(PG8_SA(1, 1), a1 + hstepA, voffA);
            PG8_WAIT_V(8); PG8_WAIT_L(0); PG8_BAR; PG8_MMA(0, 0, At, B0); PG8_MMA(0, 1, At, B1); PG8_BAR; PG8_SCHED;
            PG8_LDA(At, 0, 1); PG8_STAGE(PG8_SB(0, 0), b2, voffB); PG8_STAGE(PG8_SB(0, 1), b2 + hstepB, voffB); PG8_STAGE(PG8_SA(0, 0), a2, voffA);
            PG8_WAIT_V(8); PG8_WAIT_L(0); PG8_BAR; PG8_MMA(1, 0, At, B0); PG8_MMA(1, 1, At, B1); PG8_BAR; PG8_SCHED;
            PG8_LDB(B0, 1, 0); PG8_LDB(B1, 1, 1); PG8_SCHED; PG8_LDA(At, 1, 0); PG8_STAGE(PG8_SA(0, 1), a2 + hstepA, voffA);
            PG8_WAIT_V(8); PG8_WAIT_L(0); PG8_BAR; PG8_MMA(0, 0, At, B0); PG8_MMA(0, 1, At, B1); PG8_BAR; PG8_SCHED;
            PG8_LDA(At, 1, 1); PG8_STAGE(PG8_SB(1, 0), b3, voffB); PG8_STAGE(PG8_SB(1, 1), b3 + hstepB, voffB); PG8_STAGE(PG8_SA(1, 0), a3, voffA);
            PG8_WAIT_V(8); PG8_WAIT_L(0); PG8_BAR; PG8_MMA(1, 0, At, B0); PG8_MMA(1, 1, At, B1); PG8_BAR; PG8_SCHED;
        }
        if (wr == 0) PG8_BAR;
        run_epi(E, acc, cur, wr, wc, fr, fq);
        if (!has_next) break;
#pragma unroll
        for (int a = 0; a < 2; ++a)
#pragma unroll
            for (int b = 0; b < 2; ++b)
#pragma unroll
                for (int m = 0; m < 4; ++m)
#pragma unroll
                    for (int n = 0; n < 2; ++n) acc[a][b][m][n] = (f32x4){0.f, 0.f, 0.f, 0.f};
        cur = nxt; cA = nA; cB = nB; ++ui;
        if (wr == 1) PG8_BAR;
    }
    PG8_WAIT_V(0);
    PG8_BAR;
#undef PG8_SA
#undef PG8_SB
#undef PG8_STAGE
#undef PG8_LDA
#undef PG8_LDB
#undef PG8_MMA
#undef PG8_WAIT_V
#undef PG8_WAIT_L
#undef PG8_BAR
#undef PG8_SCHED
}
#endif
#ifndef CPU_TEST
namespace attn_body {
using bf16=__hip_bfloat16;
using bf16x8=__attribute__((ext_vector_type(8)))short;
using s16x4=__attribute__((ext_vector_type(4)))short;
using f32x16=__attribute__((ext_vector_type(16)))float;
using u32x4=__attribute__((ext_vector_type(4)))unsigned;
constexpr int SEQ=::S,D=64,QP=384,KP=128,VP=::DINP,OP=1024;
constexpr int NW=8,QBLK=32,QB=QBLK*NW,KVBLK=64,NQB=SEQ/QB;
constexpr int ATTN_UNIT_ROWS=QB;
__device__ __forceinline__ int crow(int r,int hi){return (r&3)+8*(r>>2)+4*hi;}
#define SBAR() __builtin_amdgcn_sched_barrier(0)
constexpr int NSLOT=3, SLOTB=8192;
constexpr int LDS_K=0, LDS_V=NSLOT*SLOTB, LDS_WS=2*NSLOT*SLOTB, LDS_OST=LDS_WS+NW*64*4, LDS_BYTES=LDS_OST+NW*4096;
constexpr float C2=0.125f*1.4426950408889634f;
__device__ __forceinline__ void glds16(const void*gsrc,unsigned lds_dst){unsigned keep;
  asm volatile("s_mov_b32 %0, m0\n\ts_mov_b32 m0, %2\n\ts_nop 0\n\tglobal_load_lds_dwordx4 %1, off\n\ts_mov_b32 m0, %0":"=&s"(keep):"v"(gsrc),"s"(lds_dst):"memory");}
__device__ __forceinline__ float max3f(float a,float b,float c){float r;asm("v_max3_f32 %0, %1, %2, %3":"=v"(r):"v"(a),"v"(b),"v"(c));return r;}
__device__ __forceinline__ float max2f(float a,float b){float r;asm("v_max_f32_e32 %0, %1, %2":"=v"(r):"v"(a),"v"(b));return r;}
__device__ __forceinline__ float fadd_s(float a,float b){float r;asm("v_add_f32_e32 %0, %1, %2":"=v"(r):"v"(a),"v"(b));return r;}
__device__ __forceinline__ float fsub_s(float a,float b){float r;asm("v_sub_f32_e32 %0, %1, %2":"=v"(r):"v"(a),"v"(b));return r;}
typedef float f32x2_t __attribute__((ext_vector_type(2))); typedef __bf16 bf16x2_t __attribute__((ext_vector_type(2)));
__device__ __forceinline__ unsigned cvtpk_s(float lo,float hi){f32x2_t v={lo,hi};bf16x2_t b=__builtin_convertvector(v,bf16x2_t);return __builtin_bit_cast(unsigned,b);}
#define WAIT_BAR(N) asm volatile("s_waitcnt vmcnt(" #N ") lgkmcnt(0)\n\ts_barrier":::"memory")

__device__ __forceinline__ void qkt(f32x16&p0,f32x16&p1,const char*Kslot,const bf16x8*qr,const f32x16&negm,int r32,int hi){
  const char*kb=Kslot+hi*1024+r32*16;
  #pragma unroll
  for(int d0=0;d0<4;++d0){
    const bf16x8 b0=*reinterpret_cast<const bf16x8*>(kb+d0*2048);
    const bf16x8 b1=*reinterpret_cast<const bf16x8*>(kb+d0*2048+512);
    if(d0==0){p0=__builtin_amdgcn_mfma_f32_32x32x16_bf16(b0,qr[0],negm,0,0,0);p1=__builtin_amdgcn_mfma_f32_32x32x16_bf16(b1,qr[0],negm,0,0,0);}
    else{p0=__builtin_amdgcn_mfma_f32_32x32x16_bf16(b0,qr[d0],p0,0,0,0);p1=__builtin_amdgcn_mfma_f32_32x32x16_bf16(b1,qr[d0],p1,0,0,0);}}
}
typedef __attribute__((address_space(3))) const char* lds_cptr;
typedef short v4i16_t __attribute__((ext_vector_type(4)));
__device__ __forceinline__ void kload8(bf16x8*kf,lds_cptr kp){
  kf[0]=*(const __attribute__((address_space(3))) bf16x8*)(kp);      kf[1]=*(const __attribute__((address_space(3))) bf16x8*)(kp+512);
  kf[2]=*(const __attribute__((address_space(3))) bf16x8*)(kp+2048); kf[3]=*(const __attribute__((address_space(3))) bf16x8*)(kp+2560);
  kf[4]=*(const __attribute__((address_space(3))) bf16x8*)(kp+4096); kf[5]=*(const __attribute__((address_space(3))) bf16x8*)(kp+4608);
  kf[6]=*(const __attribute__((address_space(3))) bf16x8*)(kp+6144); kf[7]=*(const __attribute__((address_space(3))) bf16x8*)(kp+6656);
}
__device__ __forceinline__ void kload2(bf16x8*kf,lds_cptr kp,int j){ kf[2*j]=*(const __attribute__((address_space(3))) bf16x8*)(kp+j*2048); kf[2*j+1]=*(const __attribute__((address_space(3))) bf16x8*)(kp+j*2048+512); }
__device__ __forceinline__ s16x4 vtr(lds_cptr p){ return __builtin_bit_cast(s16x4,__builtin_amdgcn_ds_read_tr16_b64_v4i16((__attribute__((address_space(3))) v4i16_t*)p)); }
__device__ __forceinline__ float rowmax(const f32x16&p0,const f32x16&p1){
  float a=max3f(p0[0],p0[1],p1[0]),b=max3f(p0[2],p0[3],p1[1]);a=max3f(a,p1[2],p1[3]);
  #pragma unroll
  for(int r=4;r<16;r+=4){a=max3f(a,p0[r],p0[r+1]);b=max3f(b,p0[r+2],p0[r+3]);a=max3f(a,p1[r],p1[r+1]);b=max3f(b,p1[r+2],p1[r+3]);}
  const float m=max2f(a,b);
  auto rr=__builtin_amdgcn_permlane32_swap(__float_as_uint(m),__float_as_uint(m),false,false);
  return max2f(__uint_as_float(rr[0]),__uint_as_float(rr[1]));
}
__device__ __forceinline__ void pv(f32x16*o,int vb,bf16x8 pa0,bf16x8 pa1,bf16x8 pa2,bf16x8 pa3){
  #pragma unroll
  for(int d0=0;d0<2;++d0){s16x4 lo[4],hi[4];
    #pragma unroll
    for(int ks=0;ks<4;++ks){
      asm volatile("ds_read_b64_tr_b16 %0,%1 offset:%c2":"=&v"(lo[ks]):"v"(vb),"i"(d0*4096+ks*1024):"memory");
      asm volatile("ds_read_b64_tr_b16 %0,%1 offset:%c2":"=&v"(hi[ks]):"v"(vb),"i"(d0*4096+ks*1024+512):"memory");}
    asm volatile("s_waitcnt lgkmcnt(0)":::"memory");SBAR();
    #define PK(k) (bf16x8){lo[k][0],lo[k][1],lo[k][2],lo[k][3],hi[k][0],hi[k][1],hi[k][2],hi[k][3]}
    o[d0]=__builtin_amdgcn_mfma_f32_32x32x16_bf16(pa0,PK(0),o[d0],0,0,0);
    o[d0]=__builtin_amdgcn_mfma_f32_32x32x16_bf16(pa1,PK(1),o[d0],0,0,0);
    o[d0]=__builtin_amdgcn_mfma_f32_32x32x16_bf16(pa2,PK(2),o[d0],0,0,0);
    o[d0]=__builtin_amdgcn_mfma_f32_32x32x16_bf16(pa3,PK(3),o[d0],0,0,0);
    #undef PK
  }
}

#ifndef ATTN_STORE16
#define ATTN_STORE16(p,v) (*(u32x4*)(p)=(v))
#endif
template<int THRL> __device__ __forceinline__ void attn_unit(int b,int h,int hkv,int qb,const bf16*Q,const bf16*__restrict__ K,const bf16*__restrict__ V,bf16*O,char*shm){
  const int tid=threadIdx.x,lane=tid&63,r32=lane&31,hi=lane>>5; const int wid=__builtin_amdgcn_readfirstlane(tid>>6);
  const long rowbase=(long)b*SEQ; const int q0=qb*QB;
  const bf16*Qw=Q+(rowbase+q0+wid*QBLK)*QP+h*D;
  const bf16*Kh=K+rowbase*KP+hkv*D,*Vh=V+rowbase*VP+hkv*D;
  const unsigned lds0=(unsigned)(uintptr_t)shm;
  float*wsf=(float*)(shm+LDS_WS)+wid*64;
  const bf16*ksrc=Kh+(long)lane*KP+wid*8;
  const bf16*vsrc=Vh+(long)(16*(wid&3)+(lane>>2))*VP+(wid>>2)*32+(lane&3)*8;
  const unsigned kdst=lds0+LDS_K+wid*1024, vdst=lds0+LDS_V+wid*1024;
  #define DMA_K(t,slot) glds16(ksrc+(long)(t)*KVBLK*KP,(unsigned)__builtin_amdgcn_readfirstlane(kdst+(slot)))
  #define DMA_V(t,slot) glds16(vsrc+(long)(t)*KVBLK*VP,(unsigned)__builtin_amdgcn_readfirstlane(vdst+(slot)))
  const int vb0=(int)(lds0+LDS_V)+((lane>>4)&1)*32+(lane&3)*8+(4*hi+((lane&15)>>2))*64;
  const char*Kbase=shm+LDS_K; bf16x8 kf[8];
  const lds_cptr shm3=(lds_cptr)shm; const lds_cptr kp0=shm3+LDS_K+hi*1024+r32*16; const lds_cptr vp0=shm3+LDS_V+((lane>>4)&1)*32+(lane&3)*8+(4*hi+((lane&15)>>2))*64;
  const int NT=SEQ/KVBLK;
  DMA_K(0,0);DMA_V(0,0);DMA_K(1,SLOTB);
  bf16x8 qr[4];
  #pragma unroll
  for(int d0=0;d0<4;++d0)qr[d0]=*reinterpret_cast<const bf16x8*>(&Qw[(long)r32*QP+d0*16+hi*8]);
  float mhat=0.f,l_reg=0.f;f32x16 o[2];o[0]=f32x16{};o[1]=f32x16{};f32x16 negm=f32x16{};asm volatile("":"+v"(negm));
    #define CMASK(P0,P1,t) do{}while(0)
  bool resc=false;
  #define START(P0,P1) do{ const float rm=rowmax(P0,P1); resc=false; \
    { const float dl=rm; mhat=fadd_s(mhat,dl); \
      _Pragma("unroll") for(int r=0;r<16;++r){P0[r]=fsub_s(P0[r],dl);P1[r]=fsub_s(P1[r],dl);} \
      _Pragma("unroll") for(int r=0;r<16;++r)negm[r]=-mhat; asm volatile("":"+v"(negm)); } \
    _Pragma("unroll") for(int r=0;r<16;++r)P0[r]=__builtin_amdgcn_exp2f(P0[r]); }while(0)
  #define RESC() do{ if(resc){ asm volatile("s_waitcnt lgkmcnt(0)":::"memory"); \
      _Pragma("unroll") for(int d_=0;d_<2;++d_) _Pragma("unroll") for(int r=0;r<16;++r)o[d_][r]*=wsf[crow(r,hi)]; } }while(0)
  f32x16 pA0,pA1,pB0,pB1;
  int sl_prev=0,sl_cur=0,sl_next=SLOTB;
  #define ROT() do{sl_prev=sl_cur;sl_cur=sl_next;sl_next=(sl_next==(NSLOT-1)*SLOTB)?0:sl_next+SLOTB;}while(0)
  DMA_K(2,2*SLOTB);
  WAIT_BAR(3);
  qkt(pA0,pA1,Kbase,qr,negm,r32,hi);asm volatile("s_nop 15\n\ts_nop 7":"+v"(pA0),"+v"(pA1));CMASK(pA0,pA1,0);
  START(pA0,pA1);
  _Pragma("unroll") for(int r=0;r<16;++r)pA1[r]=__builtin_amdgcn_exp2f(pA1[r]);
  WAIT_BAR(0);
  DMA_K(3,0);DMA_V(1,SLOTB);
  ROT();
  kload8(kf,kp0+sl_cur);
  WAIT_BAR(2);
  s16x4 vlo[8],vhi[8]; u32x4 pw0,pw1,pw2,pw3;
  #define PKW(P,B) cvtpk_s(P[B],P[B+1])
  #define PAF(k) __builtin_bit_cast(bf16x8,pw##k)
  #define VFR(i) (bf16x8){vlo[i][0],vlo[i][1],vlo[i][2],vlo[i][3],vhi[i][0],vhi[i][1],vhi[i][2],vhi[i][3]}
  #define PIN(x) asm volatile("":"+v"(x))
  #define MX3(a,b,c) __builtin_fmaxf(__builtin_fmaxf((a),(b)),(c))
  #define GAPA(MF,A0,A1,A2,A3,W0,W1,PW) do{ MF; sacc+=A0; sacc+=A1; sacc+=A2; sacc+=A3; PIN(sacc); W0; W1; PIN(PW); SBAR(); }while(0)
  #define EX(v) __builtin_amdgcn_exp2f(v)
  #define GAPB(MF,X,B) do{ MF; X[B]=EX(X[B]); X[B+1]=EX(X[B+1]); X[B+2]=EX(X[B+2]); X[B+3]=EX(X[B+3]); PIN(X); SBAR(); }while(0)
  #define VRD(i) do{ vlo[i]=vtr(vp_+(((i)>>2)*4096+((i)&3)*1024)); vhi[i]=vtr(vp_+(((i)>>2)*4096+((i)&3)*1024+512)); }while(0)
  #define KRD(G,j) do{ if(G){ kload2(kf,kp0+sl_next,j); SBAR(); } }while(0)
  #define STEP(C0,C1,P0,P1,t,GK,GV,GL) do{ SBAR(); \
    const lds_cptr vp_=vp0+sl_prev; \
    VRD(0); SBAR(); float sacc=(P0[0]+P0[1]); \
    GAPA(C0=__builtin_amdgcn_mfma_f32_32x32x16_bf16(kf[0],qr[0],negm,0,0,0), P0[2],P0[3],P0[4],P0[5],     pw0[0]=PKW(P0,0), pw0[1]=PKW(P0,2), pw0); \
    VRD(4); SBAR(); GAPA(C1=__builtin_amdgcn_mfma_f32_32x32x16_bf16(kf[1],qr[0],negm,0,0,0), P0[6],P0[7],P0[8],P0[9],     pw0[2]=PKW(P0,4), pw0[3]=PKW(P0,6), pw0); \
    VRD(1); SBAR(); GAPA(C0=__builtin_amdgcn_mfma_f32_32x32x16_bf16(kf[2],qr[1],C0,0,0,0),   P0[10],P0[11],P0[12],P0[13], pw1[0]=PKW(P0,8), pw1[1]=PKW(P0,10), pw1); \
    VRD(5); SBAR(); GAPA(C1=__builtin_amdgcn_mfma_f32_32x32x16_bf16(kf[3],qr[1],C1,0,0,0),   P0[14],P0[15],P1[0],P1[1],   pw1[2]=PKW(P0,12),pw1[3]=PKW(P0,14), pw1); \
    VRD(2); SBAR(); GAPA(C0=__builtin_amdgcn_mfma_f32_32x32x16_bf16(kf[4],qr[2],C0,0,0,0),   P1[2],P1[3],P1[4],P1[5],     pw2[0]=PKW(P1,0), pw2[1]=PKW(P1,2), pw2); \
    VRD(6); SBAR(); GAPA(C1=__builtin_amdgcn_mfma_f32_32x32x16_bf16(kf[5],qr[2],C1,0,0,0),   P1[6],P1[7],P1[8],P1[9],     pw2[2]=PKW(P1,4), pw2[3]=PKW(P1,6), pw2); \
    VRD(3); SBAR(); GAPA(C0=__builtin_amdgcn_mfma_f32_32x32x16_bf16(kf[6],qr[3],C0,0,0,0),   P1[10],P1[11],P1[12],P1[13], pw3[0]=PKW(P1,8), pw3[1]=PKW(P1,10), pw3); \
    VRD(7); SBAR(); GAPA(C1=__builtin_amdgcn_mfma_f32_32x32x16_bf16(kf[7],qr[3],C1,0,0,0),   P1[14],P1[15],0.f,0.f,       pw3[2]=PKW(P1,12),pw3[3]=PKW(P1,14), pw3); \
    l_reg+=sacc; \
    if(GK){DMA_K((t)+3,sl_cur);} if(GV){DMA_V((t)+1,sl_next);} \
    CMASK(C0,C1,t); \
    { float a=MX3(C0[0],C0[1],C1[0]),b=MX3(C0[2],C0[3],C1[1]); a=MX3(a,C1[2],C1[3]); \
      _Pragma("unroll") for(int r=4;r<16;r+=4){a=MX3(a,C0[r],C0[r+1]);b=MX3(b,C0[r+2],C0[r+3]);a=MX3(a,C1[r],C1[r+1]);b=MX3(b,C1[r+2],C1[r+3]);} \
      float rm=__builtin_fmaxf(a,b); { auto rr=__builtin_amdgcn_permlane32_swap(__float_as_uint(rm),__float_as_uint(rm),false,false); rm=__builtin_fmaxf(__uint_as_float(rr[0]),__uint_as_float(rr[1])); } \
      resc=false; \
      if(__builtin_expect(__any(rm>(float)THRL),0)){ const float dl=__builtin_fmaxf(rm,0.f); mhat+=dl; \
        _Pragma("unroll") for(int r=0;r<16;++r){C0[r]-=dl;C1[r]-=dl;} \
        _Pragma("unroll") for(int r=0;r<16;++r)negm[r]=-mhat; asm volatile("":"+v"(negm)); \
        const float f=__builtin_amdgcn_exp2f(-dl); l_reg*=f; if(hi==0)wsf[r32]=f; resc=true; } } \
    SBAR(); \
    GAPB(o[0]=__builtin_amdgcn_mfma_f32_32x32x16_bf16(PAF(0),VFR(0),o[0],0,0,0), C0,0); \
    GAPB(o[1]=__builtin_amdgcn_mfma_f32_32x32x16_bf16(PAF(0),VFR(4),o[1],0,0,0), C0,4); \
    KRD(GL,0); GAPB(o[0]=__builtin_amdgcn_mfma_f32_32x32x16_bf16(PAF(1),VFR(1),o[0],0,0,0), C0,8); \
    KRD(GL,1); GAPB(o[1]=__builtin_amdgcn_mfma_f32_32x32x16_bf16(PAF(1),VFR(5),o[1],0,0,0), C0,12); \
    KRD(GL,2); GAPB(o[0]=__builtin_amdgcn_mfma_f32_32x32x16_bf16(PAF(2),VFR(2),o[0],0,0,0), C1,0); \
    KRD(GL,3); GAPB(o[1]=__builtin_amdgcn_mfma_f32_32x32x16_bf16(PAF(2),VFR(6),o[1],0,0,0), C1,4); \
    GAPB(o[0]=__builtin_amdgcn_mfma_f32_32x32x16_bf16(PAF(3),VFR(3),o[0],0,0,0), C1,8); \
    GAPB(o[1]=__builtin_amdgcn_mfma_f32_32x32x16_bf16(PAF(3),VFR(7),o[1],0,0,0), C1,12); \
    }while(0)
  int t=1;
  #undef CMASK
  #define CMASK(P0,P1,t) do{}while(0)
  for(;t+5<NT;t+=2){
    STEP(pB0,pB1,pA0,pA1,t,true,true,true);     WAIT_BAR(2); RESC(); ROT();
    STEP(pA0,pA1,pB0,pB1,t+1,true,true,true);   WAIT_BAR(2); RESC(); ROT();
  }
  #undef CMASK
  #define CMASK(P0,P1,t) do{}while(0)
  #define ENDW(tt) do{ if((tt)+3<NT){WAIT_BAR(2);} else if((tt)+2<NT){WAIT_BAR(1);} else {WAIT_BAR(0);} }while(0)
  for(;t+1<NT;t+=2){
    STEP(pB0,pB1,pA0,pA1,t,(t+3<NT),(t+1<NT),(t+1<NT));       ENDW(t);   RESC(); ROT();
    STEP(pA0,pA1,pB0,pB1,t+1,(t+4<NT),(t+2<NT),(t+2<NT));     ENDW(t+1); RESC(); ROT();
  }
  STEP(pB0,pB1,pA0,pA1,NT-1,false,false,false); RESC();
  { float sacc=pB0[0]+pB0[1]; _Pragma("unroll") for(int r=2;r<16;++r)sacc+=pB0[r]; _Pragma("unroll") for(int r=0;r<16;++r)sacc+=pB1[r]; l_reg+=sacc;
    pw0=(u32x4){PKW(pB0,0),PKW(pB0,2),PKW(pB0,4),PKW(pB0,6)};pw1=(u32x4){PKW(pB0,8),PKW(pB0,10),PKW(pB0,12),PKW(pB0,14)};pw2=(u32x4){PKW(pB1,0),PKW(pB1,2),PKW(pB1,4),PKW(pB1,6)};pw3=(u32x4){PKW(pB1,8),PKW(pB1,10),PKW(pB1,12),PKW(pB1,14)};
    SBAR(); pv(o,vb0+sl_cur,PAF(0),PAF(1),PAF(2),PAF(3)); }
  #undef PKW
  #undef PAF
  #undef VFR
  #undef PIN
  #undef MX3
  #undef GAPA
  #undef GAPB
  #undef EX
  #undef VRD
  #undef KRD
  #undef STEP
  #undef ENDW
  {auto rr=__builtin_amdgcn_permlane32_swap(__float_as_uint(l_reg),__float_as_uint(l_reg),false,false);l_reg=__uint_as_float(rr[0])+__uint_as_float(rr[1]);}
  if(hi==0)wsf[32+r32]=l_reg;asm volatile("s_waitcnt lgkmcnt(0)":::"memory");
  float rli[16];
  #pragma unroll
  for(int r=0;r<16;++r)rli[r]=__builtin_amdgcn_rcpf(wsf[32+crow(r,hi)]);
  bf16*Ow=O+(rowbase+q0+wid*QBLK)*OP+h*D;
  { bf16*stg=(bf16*)(shm+LDS_OST)+wid*2048;
    #pragma unroll
    for(int r=0;r<16;++r){const int orow=crow(r,hi);
      #pragma unroll
      for(int d0=0;d0<2;++d0)stg[orow*64+d0*32+r32]=__float2bfloat16(o[d0][r]*rli[r]);}
    asm volatile("s_waitcnt lgkmcnt(0)":::"memory");
    #pragma unroll
    for(int i=0;i<4;++i){const int row=i*8+(lane>>3),ch=lane&7; const u32x4 v=*(const u32x4*)(stg+row*64+ch*8); ATTN_STORE16(Ow+(long)row*OP+ch*8,v);} }
  asm volatile("s_waitcnt lgkmcnt(0)\n\ts_barrier":::"memory");
  #undef DMA_K
  #undef DMA_V
  #undef CMASK
  #undef START
  #undef RESC
  #undef ROT
}
constexpr int ATTN_LDS_BYTES=LDS_BYTES;
struct AttnTensors { const bf16* Q; const bf16* K; const bf16* V; bf16* O; };
constexpr int N_UNITS=::NB*6*(SEQ/QB);
template<int THRL=8> __device__ __forceinline__ void attn_phase(char*lds,const AttnTensors&T,int G,int blk){
  for(int u=blk;u<N_UNITS;u+=G){ const int qb=u%(SEQ/QB), bh=u/(SEQ/QB), hq=bh%6, b=bh/6; attn_unit<THRL>(b,hq,hq/3,qb,T.Q,T.K,T.V,T.O,lds); }
}
#undef SBAR
#undef WAIT_BAR
}

#endif
#ifdef CPU_TEST
#define LN_ for (int l_ = 0; l_ < 64; ++l_)
struct vf { float v[64]; vf() {} vf(float s) { LN_ v[l_] = s; } };
struct vi { int v[64]; vi() {} vi(int s) { LN_ v[l_] = s; } };
struct vu { unsigned v[64]; vu() {} vu(unsigned s) { LN_ v[l_] = s; } };
struct vb { bool v[64]; };
#define VOP2(T, op) inline T operator op(const T& a, const T& b) { T r; LN_ r.v[l_] = a.v[l_] op b.v[l_]; return r; }
VOP2(vf, +) VOP2(vf, -) VOP2(vf, *) VOP2(vf, /) VOP2(vi, +) VOP2(vi, -) VOP2(vi, *) VOP2(vi, &) VOP2(vi, |) VOP2(vi, ^) VOP2(vu, |) VOP2(vu, &)
inline vf operator-(const vf& a) { vf r; LN_ r.v[l_] = -a.v[l_]; return r; }
inline vi operator>>(const vi& a, int s) { vi r; LN_ r.v[l_] = a.v[l_] >> s; return r; }
inline vi operator<<(const vi& a, int s) { vi r; LN_ r.v[l_] = a.v[l_] << s; return r; }
inline vu operator>>(const vu& a, int s) { vu r; LN_ r.v[l_] = a.v[l_] >> s; return r; }
inline vu operator<<(const vu& a, int s) { vu r; LN_ r.v[l_] = a.v[l_] << s; return r; }
#define VCMP(name, op) inline vb name(const vi& a, const vi& b) { vb r; LN_ r.v[l_] = a.v[l_] op b.v[l_]; return r; }
VCMP(vlt, <) VCMP(vle, <=) VCMP(vgt, >) VCMP(vge, >=) VCMP(veq, ==)
inline vf vsel(const vb& c, const vf& a, const vf& b) { vf r; LN_ r.v[l_] = c.v[l_] ? a.v[l_] : b.v[l_]; return r; }
inline vi vsel(const vb& c, const vi& a, const vi& b) { vi r; LN_ r.v[l_] = c.v[l_] ? a.v[l_] : b.v[l_]; return r; }
inline vf vexp(const vf& a) { vf r; LN_ r.v[l_] = expf(a.v[l_]); return r; }
inline vf vmin(const vf& a, const vf& b) { vf r; LN_ r.v[l_] = a.v[l_] < b.v[l_] ? a.v[l_] : b.v[l_]; return r; }
inline vf vmax(const vf& a, const vf& b) { vf r; LN_ r.v[l_] = a.v[l_] > b.v[l_] ? a.v[l_] : b.v[l_]; return r; }
inline vf vexp2(const vf& a) { vf r; LN_ r.v[l_] = exp2f(a.v[l_]); return r; }
inline vf vlog(const vf& a) { vf r; LN_ r.v[l_] = logf(a.v[l_]); return r; }
inline vf vrsqrt(const vf& a) { vf r; LN_ r.v[l_] = 1.0f / sqrtf(a.v[l_]); return r; }
inline vi lane_iota() { vi r; LN_ r.v[l_] = l_; return r; }
inline vu as_vu(const vf& a) { vu r; LN_ __builtin_memcpy(&r.v[l_], &a.v[l_], 4); return r; }
inline vf as_vf(const vu& a) { vf r; LN_ __builtin_memcpy(&r.v[l_], &a.v[l_], 4); return r; }
inline vu pack2(const vf& lo, const vf& hi) { vu r; LN_ r.v[l_] = pk2(lo.v[l_], hi.v[l_]); return r; }
inline vf bf_lo(const vu& a) { vf r; LN_ r.v[l_] = bf2f((bf16_t)(a.v[l_] & 0xffffu)); return r; }
inline vf bf_hi(const vu& a) { vf r; LN_ r.v[l_] = bf2f((bf16_t)(a.v[l_] >> 16)); return r; }
inline float rdlane(const vf& a, int l) { return a.v[l]; }
inline vf shfl(const vf& a, const vi& src) { vf r; LN_ r.v[l_] = a.v[src.v[l_] & 63]; return r; }
struct uf4 { float x[4]; };
typedef unsigned char* Lds;
inline vf g_ld_bf16(const bf16_t* p, const vi& i) { vf r; LN_ r.v[l_] = bf2f(p[i.v[l_]]); return r; }
inline vf g_ld_f32(const float* p, const vi& i) { vf r; LN_ r.v[l_] = p[i.v[l_]]; return r; }
inline void g_st_f32(float* p, const vi& i, const vf& x) { LN_ p[i.v[l_]] = x.v[l_]; }
inline void g_st_bf16(bf16_t* p, const vi& i, const vf& x) { LN_ p[i.v[l_]] = f2bf(x.v[l_]); }
inline vu g_ld_u32(const void* p, const vi& byteoff) { vu r; LN_ __builtin_memcpy(&r.v[l_], (const char*)p + byteoff.v[l_], 4); return r; }
inline void g_st_u32(void* p, const vi& byteoff, const vu& x) { LN_ __builtin_memcpy((char*)p + byteoff.v[l_], &x.v[l_], 4); }
inline vu l_ld_u32(Lds L, const vi& a) { vu r; LN_ __builtin_memcpy(&r.v[l_], L + a.v[l_], 4); return r; }
inline void l_st_u32(Lds L, const vi& a, const vu& x) { LN_ __builtin_memcpy(L + a.v[l_], &x.v[l_], 4); }
inline void l_st_u16(Lds L, const vi& a, const vu& x) { LN_ { unsigned short h = (unsigned short)x.v[l_]; __builtin_memcpy(L + a.v[l_], &h, 2); } }
inline uf4 l_ld_bcast4(Lds L, int a) { uf4 r; __builtin_memcpy(r.x, L + a, 16); return r; }
#else
typedef float vf; typedef int vi; typedef unsigned vu; typedef bool vb;
DEV vb vlt(vi a, vi b) { return a < b; } DEV vb vle(vi a, vi b) { return a <= b; } DEV vb vgt(vi a, vi b) { return a > b; } DEV vb vge(vi a, vi b) { return a >= b; } DEV vb veq(vi a, vi b) { return a == b; }
DEV vf vsel(vb c, vf a, vf b) { return c ? a : b; }
DEV vi vsel(vb c, vi a, vi b) { return c ? a : b; }
DEV vf vexp(vf a) { return __expf(a); }
DEV vf vmin(vf a, vf b) { return fminf(a, b); }
DEV vf vmax(vf a, vf b) { return fmaxf(a, b); }
DEV vf vexp2(vf a) { return __builtin_amdgcn_exp2f(a); }
DEV vf vlog(vf a) { return __logf(a); }
DEV vf vrsqrt(vf a) { return __builtin_amdgcn_rsqf(a); }
DEV vu as_vu(vf a) { return __builtin_bit_cast(unsigned, a); }
DEV vf as_vf(vu a) { return __builtin_bit_cast(float, a); }
DEV vu pack2(vf lo, vf hi) { typedef float f2_ __attribute__((ext_vector_type(2))); typedef __bf16 b2_ __attribute__((ext_vector_type(2))); f2_ v = {lo, hi}; return __builtin_bit_cast(unsigned, __builtin_convertvector(v, b2_)); }
DEV vf bf_lo(vu a) { return __builtin_bit_cast(float, a << 16); }
DEV vf bf_hi(vu a) { return __builtin_bit_cast(float, a & 0xffff0000u); }
DEV float rdlane(vf a, int l) { return __builtin_bit_cast(float, __builtin_amdgcn_readlane(__builtin_bit_cast(int, a), l)); }
DEV vf shfl(vf a, vi src) { return __builtin_bit_cast(float, __builtin_amdgcn_ds_bpermute(src << 2, __builtin_bit_cast(int, a))); }
typedef f32x4 uf4_t; struct uf4 { float x[4]; };
typedef LAS unsigned char* Lds;
DEV vf g_ld_bf16(const bf16_t* p, vi i) { return __builtin_bit_cast(float, (unsigned)p[i] << 16); }
DEV vf g_ld_f32(const float* p, vi i) { return p[i]; }
DEV void g_st_f32(float* p, vi i, vf x) { p[i] = x; }
DEV void g_st_bf16(bf16_t* p, vi i, vf x) { p[i] = (bf16_t)(pack2(x, 0.f) & 0xffffu); }
DEV vu g_ld_u32(const void* p, vi byteoff) { return *(const unsigned*)((const char*)p + byteoff); }
DEV void g_st_u32(void* p, vi byteoff, vu x) { *(unsigned*)((char*)p + byteoff) = x; }
DEV vu l_ld_u32(Lds L, vi a) { return *(const LAS unsigned*)(L + a); }
DEV void l_st_u32(Lds L, vi a, vu x) { *(LAS unsigned*)(L + a) = x; }
DEV void l_st_u16(Lds L, vi a, vu x) { *(LAS unsigned short*)(L + a) = (unsigned short)x; }
DEV uf4 l_ld_bcast4(Lds L, int a) { const f32x4 v = *(const LAS f32x4*)(L + a); uf4 r; r.x[0] = v[0]; r.x[1] = v[1]; r.x[2] = v[2]; r.x[3] = v[3]; return r; }
#endif
struct frag8 { vu w[4]; };
struct frag4 { vu w[2]; };
struct acc4 { vf r[4]; };
DEV frag8 join(const frag4& lo, const frag4& hi) { frag8 f; f.w[0] = lo.w[0]; f.w[1] = lo.w[1]; f.w[2] = hi.w[0]; f.w[3] = hi.w[1]; return f; }
DEV frag4 cvt4(const acc4& a) { frag4 f; f.w[0] = pack2(a.r[0], a.r[1]); f.w[1] = pack2(a.r[2], a.r[3]); return f; }
DEV acc4 uncvt4(const frag4& f) { acc4 a; a.r[0] = bf_lo(f.w[0]); a.r[1] = bf_hi(f.w[0]); a.r[2] = bf_lo(f.w[1]); a.r[3] = bf_hi(f.w[1]); return a; }
DEV acc4 acc_zero() { acc4 a; a.r[0] = vf(0.f); a.r[1] = vf(0.f); a.r[2] = vf(0.f); a.r[3] = vf(0.f); return a; }
DEV frag4 frag4_zero() { frag4 f; f.w[0] = vu(0u); f.w[1] = vu(0u); return f; }
#ifdef CPU_TEST
inline frag8 g_ld_frag8(const void* p, const vi& byteoff) { frag8 f; for (int q = 0; q < 4; ++q) f.w[q] = g_ld_u32(p, byteoff + vi(4 * q)); return f; }
inline frag4 g_ld_frag4(const void* p, const vi& byteoff) { frag4 f; for (int q = 0; q < 2; ++q) f.w[q] = g_ld_u32(p, byteoff + vi(4 * q)); return f; }
inline void g_st_frag8(void* p, const vi& byteoff, const frag8& f) { for (int q = 0; q < 4; ++q) g_st_u32(p, byteoff + vi(4 * q), f.w[q]); }
inline void g_st_frag4(void* p, const vi& byteoff, const frag4& f) { for (int q = 0; q < 2; ++q) g_st_u32(p, byteoff + vi(4 * q), f.w[q]); }
inline frag8 l_ld_frag8(Lds L, const vi& a) { frag8 f; for (int q = 0; q < 4; ++q) f.w[q] = l_ld_u32(L, a + vi(4 * q)); return f; }
inline frag4 l_ld_frag4(Lds L, const vi& a) { frag4 f; for (int q = 0; q < 2; ++q) f.w[q] = l_ld_u32(L, a + vi(4 * q)); return f; }
inline void l_st_frag8(Lds L, const vi& a, const frag8& f) { for (int q = 0; q < 4; ++q) l_st_u32(L, a + vi(4 * q), f.w[q]); }
inline void l_st_frag4(Lds L, const vi& a, const frag4& f) { for (int q = 0; q < 2; ++q) l_st_u32(L, a + vi(4 * q), f.w[q]); }
inline float frag_elem(const frag8& f, int lane, int e) { const unsigned w = f.w[e >> 1].v[lane]; return bf2f((bf16_t)((e & 1) ? (w >> 16) : (w & 0xffffu))); }
inline acc4 mfma(const frag8& a, const frag8& b, const acc4& c) { acc4 d;
    for (int l = 0; l < 64; ++l) { const int j = l & 15, g = l >> 4;
        for (int r = 0; r < 4; ++r) { const int i = 4 * g + r; float s = c.r[r].v[l];
            for (int k = 0; k < 32; ++k) s += frag_elem(a, i + 16 * (k >> 3), k & 7) * frag_elem(b, j + 16 * (k >> 3), k & 7);
            d.r[r].v[l] = s; } }
    return d; }
#else
DEV frag8 g_ld_frag8(const void* p, vi byteoff) { const u32x4 v = *(const u32x4*)((const char*)p + byteoff); frag8 f; f.w[0] = v[0]; f.w[1] = v[1]; f.w[2] = v[2]; f.w[3] = v[3]; return f; }
DEV frag4 g_ld_frag4(const void* p, vi byteoff) { const u32x2 v = *(const u32x2*)((const char*)p + byteoff); frag4 f; f.w[0] = v[0]; f.w[1] = v[1]; return f; }
DEV void g_st_frag8(void* p, vi byteoff, const frag8& f) { *(u32x4*)((char*)p + byteoff) = (u32x4){f.w[0], f.w[1], f.w[2], f.w[3]}; }
DEV void g_st_frag4(void* p, vi byteoff, const frag4& f) { *(u32x2*)((char*)p + byteoff) = (u32x2){f.w[0], f.w[1]}; }
DEV frag8 l_ld_frag8(Lds L, vi a) { const u32x4 v = *(const LAS u32x4*)(L + a); frag8 f; f.w[0] = v[0]; f.w[1] = v[1]; f.w[2] = v[2]; f.w[3] = v[3]; return f; }
DEV frag4 l_ld_frag4(Lds L, vi a) { const u32x2 v = *(const LAS u32x2*)(L + a); frag4 f; f.w[0] = v[0]; f.w[1] = v[1]; return f; }
DEV void l_st_frag8(Lds L, vi a, const frag8& f) { *(LAS u32x4*)(L + a) = (u32x4){f.w[0], f.w[1], f.w[2], f.w[3]}; }
DEV void l_st_frag4(Lds L, vi a, const frag4& f) { *(LAS u32x2*)(L + a) = (u32x2){f.w[0], f.w[1]}; }
DEV acc4 mfma(const frag8& a, const frag8& b, const acc4& c) {
    const u32x4 av = {a.w[0], a.w[1], a.w[2], a.w[3]}, bv = {b.w[0], b.w[1], b.w[2], b.w[3]}; const f32x4 cv = {c.r[0], c.r[1], c.r[2], c.r[3]};
    const f32x4 d = __builtin_amdgcn_mfma_f32_16x16x32_bf16(__builtin_bit_cast(bf16x8, av), __builtin_bit_cast(bf16x8, bv), cv, 0, 0, 0);
    acc4 r; r.r[0] = d[0]; r.r[1] = d[1]; r.r[2] = d[2]; r.r[3] = d[3]; return r; }
#endif
DEV vf wave_scan_incl(vf x, const vi& lane) {
#pragma unroll
    for (int o = 1; o < 64; o <<= 1) { const vf y = shfl(x, lane - vi(o)); x = x + vsel(vge(lane, vi(o)), y, vf(0.f)); }
    return x;
}
constexpr int GCH = 64, GNCH = S / GCH, GSC = 2 * NB * 6;
constexpr int HCH = 32, HNCH = S / HCH, HSC = 2 * NB * 4;
DEV vi slot8(int td, int te, const vi& lane) { return (vi((te * 2 + (td >> 1)) * 64) + lane) * vi(16) + vi((td & 1) * 8); }
DEV vi tok_of(int dir, int b, const vi& s) { return vi(b * S) + (dir ? vi(S - 1) - s : s); }
DEV int tok_u(int dir, int b, int s) { return b * S + (dir ? S - 1 - s : s); }
DEV vi swz(const vi& row, int chunk) { return row * vi(128) + ((vi(chunk) ^ (row & vi(7))) << 4); }

struct HChunk { int dir, b, h, n; };
DEV HChunk hchunk(int item) { HChunk c; c.n = item % HNCH; const int sc = item / HNCH; c.h = sc % 4; c.b = (sc / 4) % NB; c.dir = sc / (4 * NB); return c; }
DEV void hgrn_m1(const PRef p, Lds L, const vi& lane, int item) {
    const HChunk c = hchunk(item);
    const bf16_t* KIN = WSP(const bf16_t, O_KIN) + (size_t)c.dir * NTOK * 256; const bf16_t* proj = WSP(const bf16_t, O_PROJ);
    vf cum(0.f); vf cums[HCH]; vu kp[HCH / 2], vp[HCH / 2];
#pragma unroll
    for (int i = 0; i < HCH; i += 2) { const int t0 = tok_u(c.dir, c.b, c.n * HCH + i), t1 = tok_u(c.dir, c.b, c.n * HCH + i + 1);
        const vf k0 = g_ld_bf16(KIN, vi(t0 * 256 + c.h * 64) + lane), k1 = g_ld_bf16(KIN, vi(t1 * 256 + c.h * 64) + lane);
        cum = cum + vlog(vf(1.f) - k0); cums[i] = cum; cum = cum + vlog(vf(1.f) - k1); cums[i + 1] = cum; kp[i / 2] = pack2(k0, k1);
        vp[i / 2] = pack2(g_ld_bf16(proj, vi(t0 * DINP + C_CI + c.h * 64) + lane), g_ld_bf16(proj, vi(t1 * DINP + C_CI + c.h * 64) + lane)); }
    g_st_f32(WSP(float, O_HCD), vi(item * 64) + lane, vexp(cum));
#pragma unroll
    for (int q = 0; q < 4; ++q) { frag8 fv, fk;
#pragma unroll
        for (int w = 0; w < 4; ++w) { fv.w[w] = vp[4 * q + w]; fk.w[w] = pack2(bf_lo(kp[4 * q + w]) * vexp(cum - cums[8 * q + 2 * w]), bf_hi(kp[4 * q + w]) * vexp(cum - cums[8 * q + 2 * w + 1])); }
        l_st_frag8(L, lane * vi(80) + vi(16 * q), fv); l_st_frag8(L, vi(5120) + lane * vi(80) + vi(16 * q), fk); }
    void* LOC = (void*)(WSP(unsigned char, O_HLS) + (size_t)item * 8192);
    const vi fr = lane & vi(15), fq = lane >> 4;
#pragma unroll
    for (int td = 0; td < 4; ++td) { const frag8 P = l_ld_frag8(L, vi(5120) + (vi(16 * td) + fr) * vi(80) + fq * vi(16));
#pragma unroll
        for (int te = 0; te < 4; ++te) { const frag8 Q = l_ld_frag8(L, (vi(16 * te) + fr) * vi(80) + fq * vi(16));
            const acc4 d = mfma(P, Q, acc_zero());
            g_st_frag4(LOC, slot8(td, te, lane), cvt4(d)); } }
}
DEV void hgrn_m2(const PRef p, const vi& lane, int item) {
    const int sc = item / 16, td = (item % 16) / 4, te = item % 4;
    acc4 st = acc_zero(); const vi g4 = (lane >> 4) << 2;
    unsigned char* base = WSP(unsigned char, O_HLS) + (size_t)sc * HNCH * 8192; const float* CD = WSP(const float, O_HCD) + (size_t)sc * HNCH * 64;
    const vi so = slot8(td, te, lane);
#pragma unroll 8
    for (int n = 0; n < HNCH; ++n) {
        const acc4 loc = uncvt4(g_ld_frag4(base + (size_t)n * 8192, so));
        g_st_frag4(base + (size_t)n * 8192, so, cvt4(st));
#pragma unroll
        for (int r = 0; r < 4; ++r) st.r[r] = g_ld_f32(CD, vi(n * 64 + 16 * td + r) + g4) * st.r[r] + loc.r[r];
    }
}
DEV void hgrn_m3(const PRef p, Lds L, const vi& lane, int item) {
    const HChunk c = hchunk(item);
    const bf16_t* KIN = WSP(const bf16_t, O_KIN) + (size_t)c.dir * NTOK * 256; const bf16_t* CQ = WSP(const bf16_t, O_CQ); const bf16_t* proj = WSP(const bf16_t, O_PROJ);
    const vi fr = lane & vi(15), fq = lane >> 4;
    { vf cum(0.f); vu vp[HCH / 2];
#pragma unroll
      for (int i = 0; i < HCH; i += 2) { const int t0 = tok_u(c.dir, c.b, c.n * HCH + i), t1 = tok_u(c.dir, c.b, c.n * HCH + i + 1);
        const vf k0 = g_ld_bf16(KIN, vi(t0 * 256 + c.h * 64) + lane), k1 = g_ld_bf16(KIN, vi(t1 * 256 + c.h * 64) + lane);
        const vf q0 = g_ld_bf16(CQ, vi(t0 * 256 + c.h * 64) + lane), q1 = g_ld_bf16(CQ, vi(t1 * 256 + c.h * 64) + lane);
        cum = cum + vlog(vf(1.f) - k0); l_st_u16(L, vi(i * 144) + lane * vi(2), pack2(q0 * vexp(cum), vf(0.f))); l_st_u16(L, vi(4608 + i * 144) + lane * vi(2), pack2(k0 * vexp(vmin(-cum, vf(80.f))), vf(0.f)));
        cum = cum + vlog(vf(1.f) - k1); l_st_u16(L, vi((i + 1) * 144) + lane * vi(2), pack2(q1 * vexp(cum), vf(0.f))); l_st_u16(L, vi(4608 + (i + 1) * 144) + lane * vi(2), pack2(k1 * vexp(vmin(-cum, vf(80.f))), vf(0.f)));
        vp[i / 2] = pack2(g_ld_bf16(proj, vi(t0 * DINP + C_CI + c.h * 64) + lane), g_ld_bf16(proj, vi(t1 * DINP + C_CI + c.h * 64) + lane)); }
#pragma unroll
      for (int q = 0; q < 4; ++q) { frag8 fv;
#pragma unroll
        for (int w = 0; w < 4; ++w) fv.w[w] = vp[4 * q + w];
        l_st_frag8(L, vi(9216) + lane * vi(80) + vi(16 * q), fv); } }
    frag8 PX[2];
#pragma unroll
    for (int ti = 0; ti < 2; ++ti) { frag4 h[2];
#pragma unroll
        for (int tj = 0; tj < 2; ++tj) {
            if (tj > ti) { h[tj] = frag4_zero(); continue; }
            acc4 d = acc_zero();
#pragma unroll
            for (int ks = 0; ks < 2; ++ks) d = mfma(l_ld_frag8(L, vi(4608) + (vi(16 * tj) + fr) * vi(144) + vi(64 * ks) + fq * vi(16)), l_ld_frag8(L, (vi(16 * ti) + fr) * vi(144) + vi(64 * ks) + fq * vi(16)), d);
#pragma unroll
            for (int r = 0; r < 4; ++r) d.r[r] = vsel(vle(vi(16 * tj + r) + (fq << 2), vi(16 * ti) + fr), d.r[r], vf(0.f));
            h[tj] = cvt4(d); }
        PX[ti] = join(h[0], h[1]); }
    const unsigned char* ST = WSP(const unsigned char, O_HLS) + (size_t)item * 8192;
    bf16_t* OC = WSP(bf16_t, O_OC16) + (size_t)c.dir * NTOK * 256;
#pragma unroll
    for (int te = 0; te < 4; ++te) {
        const frag8 S0 = g_ld_frag8(ST, (vi((te * 2 + 0) * 64) + lane) * vi(16)), S1 = g_ld_frag8(ST, (vi((te * 2 + 1) * 64) + lane) * vi(16));
        const frag8 QV = join(l_ld_frag4(L, vi(9216) + (vi(16 * te) + fr) * vi(80) + fq * vi(8)), l_ld_frag4(L, vi(9216) + (vi(16 * te) + fr) * vi(80) + vi(32) + fq * vi(8)));
#pragma unroll
        for (int ti = 0; ti < 2; ++ti) {
            const vi rowb = (vi(16 * ti) + fr) * vi(144) + fq * vi(8);
            acc4 o = mfma(join(l_ld_frag4(L, rowb), l_ld_frag4(L, rowb + vi(32))), S0, acc_zero());
            o = mfma(join(l_ld_frag4(L, rowb + vi(64)), l_ld_frag4(L, rowb + vi(96))), S1, o);
            o = mfma(PX[ti], QV, o);
#pragma unroll
            for (int r = 0; r < 4; ++r) g_st_bf16(OC, tok_of(c.dir, c.b, vi(c.n * HCH + 16 * ti + r) + (fq << 2)) * vi(256) + vi(c.h * 64 + 16 * te) + fr, o.r[r]); } }
}

struct GChunk { int dir, b, h, n; };
DEV GChunk gchunk(int item) { GChunk c; c.n = item % GNCH; const int sc = item / GNCH; c.h = sc % 6; c.b = (sc / 6) % NB; c.dir = sc / (6 * NB); return c; }
DEV void gdn_solve(Lds L, const vi& lane) {
    for (int i = 1; i < GCH; ++i) {
        vf a = as_vf(l_ld_u32(L, vi(16384 + i * 256) + lane * vi(4))), a2 = vf(0.f);
        for (int m8 = 0; m8 * 8 < i; ++m8) {
            const uf4 la = l_ld_bcast4(L, (i * 64 + 8 * m8) * 4), lb = l_ld_bcast4(L, (i * 64 + 8 * m8 + 4) * 4);
            vf xv[8];
#pragma unroll
            for (int q = 0; q < 8; ++q) xv[q] = as_vf(l_ld_u32(L, vi(16384 + (8 * m8 + q) * 256) + lane * vi(4)));
#pragma unroll
            for (int q = 0; q < 4; ++q) { a = a - vf(la.x[q]) * xv[q]; a2 = a2 - vf(lb.x[q]) * xv[4 + q]; }
        }
        l_st_u32(L, vi(16384 + i * 256) + lane * vi(4), as_vu(a + a2));
    }
}
DEV vi swz8(const vi& row, const vi& t) { return row * vi(128) + (((t >> 3) ^ (row & vi(7))) << 4) + ((t & vi(7)) << 1); }
DEV void gdn_m1(const PRef p, Lds L, const vi& lane, int item) {
    const GChunk c = gchunk(item);
    const bf16_t* AK = WSP(const bf16_t, O_AK); const bf16_t* AV = WSP(const bf16_t, O_AV);
    const vi fr = lane & vi(15), fq = lane >> 4;
    const vi tokl = tok_of(c.dir, c.b, vi(c.n * GCH) + lane);
    const vf g = g_ld_f32(WSP(const float, O_GG) + (size_t)c.dir * NTOK * 6, tokl * vi(6) + vi(c.h)), beta = g_ld_f32(WSP(const float, O_BETA) + (size_t)c.dir * NTOK * 6, tokl * vi(6) + vi(c.h));
    const vf gc = wave_scan_incl(g, lane), eg = vexp(gc); const float gl = rdlane(gc, 63);
    const vf kscale = vexp(vf(gl) - gc);
    { frag8 Kf[4][2];
#pragma unroll
      for (int t4 = 0; t4 < 4; ++t4)
#pragma unroll
        for (int ks = 0; ks < 2; ++ks) Kf[t4][ks] = g_ld_frag8(AK, (tok_of(c.dir, c.b, vi(c.n * GCH + 16 * t4) + fr) * vi(384) + vi(c.h * 64 + 32 * ks) + (fq << 3)) * vi(2));
#pragma unroll
      for (int ti = 0; ti < 4; ++ti)
#pragma unroll
        for (int tj = 0; tj < 4; ++tj) { const vi j = vi(16 * tj) + fr;
            if (tj > ti) {
#pragma unroll
                for (int r = 0; r < 4; ++r) l_st_u32(L, ((vi(16 * ti + r) + (fq << 2)) * vi(64) + j) * vi(4), vu(0u));
                continue; }
            acc4 d = mfma(Kf[ti][0], Kf[tj][0], acc_zero()); d = mfma(Kf[ti][1], Kf[tj][1], d);
            const vf gcj = shfl(gc, j);
#pragma unroll
            for (int r = 0; r < 4; ++r) { const vi i = vi(16 * ti + r) + (fq << 2); const vf v = shfl(beta, i) * d.r[r] * vexp(shfl(gc, i) - gcj);
                l_st_u32(L, (i * vi(64) + j) * vi(4), as_vu(vsel(vlt(j, i), v, vf(0.f)))); } } }
#if defined(GM1_STOP) && GM1_STOP <= 1
    return;
#endif
    const size_t cb = (size_t)item * 8192;
    unsigned char* GU = WSP(unsigned char, O_GU) + cb;
    for (int i = 0; i < GCH; ++i) l_st_u32(L, vi(16384 + i * 256) + lane * vi(4), as_vu(g_ld_bf16(AV, vi(tok_u(c.dir, c.b, c.n * GCH + i) * 384 + c.h * 64) + lane) * vf(rdlane(beta, i))));
    gdn_solve(L, lane);
#if defined(GM1_STOP) && GM1_STOP <= 2
    return;
#endif
#pragma unroll
    for (int ti = 0; ti < 4; ++ti)
#pragma unroll
        for (int g4 = 0; g4 < 4; ++g4) { vf x4[4];
#pragma unroll
            for (int r = 0; r < 4; ++r) x4[r] = as_vf(l_ld_u32(L, vi(16384 + (16 * ti + 4 * g4 + r) * 256) + lane * vi(4)));
            frag4 f; f.w[0] = pack2(x4[0], x4[1]); f.w[1] = pack2(x4[2], x4[3]);
            g_st_frag4(GU, (((vi(ti * 4) + fq) * vi(64)) + vi(16 * g4) + fr) * vi(8), f); }
    { const vf rs = beta * eg;
      for (int i = 0; i < GCH; ++i) l_st_u32(L, vi(16384 + i * 256) + lane * vi(4), as_vu(g_ld_bf16(AK, vi(tok_u(c.dir, c.b, c.n * GCH + i) * 384 + c.h * 64) + lane) * vf(rdlane(rs, i)))); }
    gdn_solve(L, lane);
#if defined(GM1_STOP) && GM1_STOP <= 3
    return;
#endif
    { bf16_t* GW = (bf16_t*)(WSP(unsigned char, O_GW) + cb);
#pragma unroll
      for (int q = 0; q < 8; ++q) { frag8 fk, fw;
#pragma unroll
        for (int w = 0; w < 4; ++w) { const int t0 = 8 * q + 2 * w;
            const vf w0 = -as_vf(l_ld_u32(L, vi(16384 + t0 * 256) + lane * vi(4))), w1 = -as_vf(l_ld_u32(L, vi(16384 + (t0 + 1) * 256) + lane * vi(4)));
            g_st_bf16(GW, vi(t0 * 64) + lane, w0); g_st_bf16(GW, vi((t0 + 1) * 64) + lane, w1); fw.w[w] = pack2(w0, w1);
            fk.w[w] = pack2(g_ld_bf16(AK, vi(tok_u(c.dir, c.b, c.n * GCH + t0) * 384 + c.h * 64) + lane) * vf(rdlane(kscale, t0)), g_ld_bf16(AK, vi(tok_u(c.dir, c.b, c.n * GCH + t0 + 1) * 384 + c.h * 64) + lane) * vf(rdlane(kscale, t0 + 1))); }
        l_st_frag8(L, swz(lane, q), fk); l_st_frag8(L, vi(8192) + swz(lane, q), fw); } }
    frag8 KD[4][2];
#pragma unroll
    for (int td = 0; td < 4; ++td)
#pragma unroll
        for (int s2 = 0; s2 < 2; ++s2) { const vi row = vi(16 * td) + fr; KD[td][s2] = join(l_ld_frag4(L, swz8(row, vi(32 * s2) + (fq << 2))), l_ld_frag4(L, swz8(row, vi(32 * s2 + 16) + (fq << 2)))); }
#if defined(GM1_STOP) && GM1_STOP <= 4
    return;
#endif
    unsigned char* GC = WSP(unsigned char, O_GCS) + cb;
#pragma unroll
    for (int te = 0; te < 4; ++te) { const frag8 U0 = join(g_ld_frag4(GU, (vi((0 * 4 + te) * 64) + lane) * vi(8)), g_ld_frag4(GU, (vi((1 * 4 + te) * 64) + lane) * vi(8))), U1 = join(g_ld_frag4(GU, (vi((2 * 4 + te) * 64) + lane) * vi(8)), g_ld_frag4(GU, (vi((3 * 4 + te) * 64) + lane) * vi(8)));
#pragma unroll
        for (int td = 0; td < 4; ++td) { acc4 d = mfma(KD[td][0], U0, acc_zero()); d = mfma(KD[td][1], U1, d);
            g_st_frag4(GC, slot8(td, te, lane), cvt4(d)); } }
    bf16_t* GM = (bf16_t*)(WSP(unsigned char, O_GM) + cb); const float cdl = expf(gl);
#pragma unroll
    for (int t2 = 0; t2 < 4; ++t2) { const vi row = vi(16 * t2) + fr;
        const frag8 W0 = join(l_ld_frag4(L, vi(8192) + swz8(row, (fq << 2))), l_ld_frag4(L, vi(8192) + swz8(row, vi(16) + (fq << 2)))), W1 = join(l_ld_frag4(L, vi(8192) + swz8(row, vi(32) + (fq << 2))), l_ld_frag4(L, vi(8192) + swz8(row, vi(48) + (fq << 2))));
#pragma unroll
        for (int td = 0; td < 4; ++td) { acc4 d = mfma(KD[td][0], W0, acc_zero()); d = mfma(KD[td][1], W1, d);
#pragma unroll
            for (int r = 0; r < 4; ++r) { const vi dd = vi(16 * td + r) + (fq << 2), d2 = vi(16 * t2) + fr; const vf v = d.r[r] + vsel(veq(dd, d2), vf(cdl), vf(0.f));
                g_st_bf16(GM, ((vi((td * 2 + (t2 >> 1)) * 64) + ((fr >> 2) << 4) + (fq << 2) + vi(r)) << 3) + vi(4 * (t2 & 1)) + (fr & vi(3)), v); } } }
}
DEV void gdn_m2(const PRef p, const vi& lane, int item) {
    const int sc = item / 4, te = item % 4;
    acc4 st[4];
#pragma unroll
    for (int td = 0; td < 4; ++td) st[td] = acc_zero();
    unsigned char* CS = WSP(unsigned char, O_GCS) + (size_t)sc * GNCH * 8192; const unsigned char* GM = WSP(const unsigned char, O_GM) + (size_t)sc * GNCH * 8192;
#pragma unroll 2
    for (int n = 0; n < GNCH; ++n) {
        const frag8 S0 = join(cvt4(st[0]), cvt4(st[1])), S1 = join(cvt4(st[2]), cvt4(st[3]));
        acc4 nx[4];
#pragma unroll
        for (int td = 0; td < 4; ++td) nx[td] = uncvt4(g_ld_frag4(CS + (size_t)n * 8192, slot8(td, te, lane)));
        g_st_frag8(CS + (size_t)n * 8192, (vi((te * 2 + 0) * 64) + lane) * vi(16), S0); g_st_frag8(CS + (size_t)n * 8192, (vi((te * 2 + 1) * 64) + lane) * vi(16), S1);
#pragma unroll
        for (int td = 0; td < 4; ++td) { nx[td] = mfma(g_ld_frag8(GM + (size_t)n * 8192, (vi((td * 2 + 0) * 64) + lane) * vi(16)), S0, nx[td]);
            st[td] = mfma(g_ld_frag8(GM + (size_t)n * 8192, (vi((td * 2 + 1) * 64) + lane) * vi(16)), S1, nx[td]); }
    }
}
DEV void gdn_m3(const PRef p, const vi& lane, int item) {
    const GChunk c = gchunk(item);
    const bf16_t* AK = WSP(const bf16_t, O_AK); const bf16_t* AQ = WSP(const bf16_t, O_AQ);
    const vi fr = lane & vi(15), fq = lane >> 4;
    const vi tokl = tok_of(c.dir, c.b, vi(c.n * GCH) + lane);
    const vf g = g_ld_f32(WSP(const float, O_GG) + (size_t)c.dir * NTOK * 6, tokl * vi(6) + vi(c.h));
    const vf gc = wave_scan_incl(g, lane), eg = vexp(gc);
    const size_t cb = (size_t)item * 8192;
    frag8 PA[4][2];
    { frag8 Kf[4][2], Qf[4][2];
#pragma unroll
      for (int t4 = 0; t4 < 4; ++t4)
#pragma unroll
        for (int ks = 0; ks < 2; ++ks) { const vi off = (tok_of(c.dir, c.b, vi(c.n * GCH + 16 * t4) + fr) * vi(384) + vi(c.h * 64 + 32 * ks) + (fq << 3)) * vi(2); Kf[t4][ks] = g_ld_frag8(AK, off); Qf[t4][ks] = g_ld_frag8(AQ, off); }
#pragma unroll
      for (int ti = 0; ti < 4; ++ti) { frag4 h[4]; const vf gci = shfl(gc, vi(16 * ti) + fr);
#pragma unroll
        for (int tj = 0; tj < 4; ++tj) {
            if (tj > ti) { h[tj] = frag4_zero(); continue; }
            acc4 d = mfma(Kf[tj][0], Qf[ti][0], acc_zero()); d = mfma(Kf[tj][1], Qf[ti][1], d);
#pragma unroll
            for (int r = 0; r < 4; ++r) { const vi j = vi(16 * tj + r) + (fq << 2); d.r[r] = vsel(vle(j, vi(16 * ti) + fr), d.r[r] * vexp(gci - shfl(gc, j)), vf(0.f)); }
            h[tj] = cvt4(d); }
        PA[ti][0] = join(h[0], h[1]); PA[ti][1] = join(h[2], h[3]); } }
    FENCE();
    const unsigned char* ST = WSP(const unsigned char, O_GCS) + cb; const unsigned char* GU = WSP(const unsigned char, O_GU) + cb;
    bf16_t* OA = WSP(bf16_t, O_OA16) + (size_t)c.dir * NTOK * 384;
    const unsigned char* GW = WSP(const unsigned char, O_GW) + cb;
#pragma unroll 1
    for (int te = 0; te < 4; ++te) {
        const frag8 S0 = g_ld_frag8(ST, (vi((te * 2 + 0) * 64) + lane) * vi(16)), S1 = g_ld_frag8(ST, (vi((te * 2 + 1) * 64) + lane) * vi(16));
        frag8 WP[4][2], QP[4][2];
#pragma unroll
        for (int t4 = 0; t4 < 4; ++t4)
#pragma unroll
            for (int s = 0; s < 2; ++s) { const vi wo = ((vi(16 * t4) + fr) * vi(64) + vi(32 * s) + (fq << 2)) * vi(2); WP[t4][s] = join(g_ld_frag4(GW, wo), g_ld_frag4(GW, wo + vi(32)));
                const vi qo = (tok_of(c.dir, c.b, vi(c.n * GCH + 16 * t4) + fr) * vi(384) + vi(c.h * 64 + 32 * s) + (fq << 2)) * vi(2); QP[t4][s] = join(g_ld_frag4(AQ, qo), g_ld_frag4(AQ, qo + vi(32))); }
        frag4 vn[4];
#pragma unroll
        for (int ti = 0; ti < 4; ++ti) { acc4 a = uncvt4(g_ld_frag4(GU, (vi((ti * 4 + te) * 64) + lane) * vi(8))); a = mfma(WP[ti][0], S0, a); a = mfma(WP[ti][1], S1, a); vn[ti] = cvt4(a); }
        FENCE();
        const frag8 V0 = join(vn[0], vn[1]), V1 = join(vn[2], vn[3]);
#pragma unroll
        for (int ti = 0; ti < 4; ++ti) { acc4 o = mfma(QP[ti][0], S0, acc_zero()); o = mfma(QP[ti][1], S1, o);
#pragma unroll
            for (int r = 0; r < 4; ++r) o.r[r] = o.r[r] * shfl(eg, vi(16 * ti + r) + (fq << 2));
            o = mfma(PA[ti][0], V0, o); if (ti >= 2) o = mfma(PA[ti][1], V1, o);
#pragma unroll
            for (int r = 0; r < 4; ++r) g_st_bf16(OA, tok_of(c.dir, c.b, vi(c.n * GCH + 16 * ti + r) + (fq << 2)) * vi(384) + vi(c.h * 64 + 16 * te) + fr, o.r[r]); } }
}

constexpr int XNTM = MEMT / 16, XNKS = XHD / 32, XNTD = XHD / 16, XNS = MEMT / 32;
DEV void xattn_item(const PRef p, int l, const vi& lane, int item) {
    const int h = item % XH, n0 = (item / XH) * 16, b = n0 / S;
    const unsigned char* QX = WSP(const unsigned char, O_QX); const unsigned char* KM = WSP(const unsigned char, O_KMEM) + (size_t)l * NMEM * D * 2; const unsigned char* VT = WSP(const unsigned char, O_VT) + (size_t)l * NMEM * D * 2;
    bf16_t* OX = WSP(bf16_t, O_MIXED);
    const vi fr = lane & vi(15), fq = lane >> 4;
    frag8 Qf[XNKS];
#pragma unroll
    for (int ks = 0; ks < XNKS; ++ks) Qf[ks] = g_ld_frag8(QX, ((vi(n0) + fr) * vi(D) + vi(h * XHD + 32 * ks) + (fq << 3)) * vi(2));
    acc4 sc[XNTM]; vf mx(-3.0e38f);
#pragma unroll
    for (int tm = 0; tm < XNTM; ++tm) { acc4 d = acc_zero();
#pragma unroll
        for (int ks = 0; ks < XNKS; ++ks) d = mfma(g_ld_frag8(KM, ((vi(b * MEMT + 16 * tm) + fr) * vi(D) + vi(h * XHD + 32 * ks) + (fq << 3)) * vi(2)), Qf[ks], d);
        sc[tm] = d;
#pragma unroll
        for (int r = 0; r < 4; ++r) mx = vmax(mx, d.r[r]); }
    mx = vmax(mx, shfl(mx, lane ^ vi(16))); mx = vmax(mx, shfl(mx, lane ^ vi(32)));
    vf sum(0.f); frag8 PF[XNS];
#pragma unroll
    for (int s2 = 0; s2 < XNS; ++s2) { frag4 hh[2];
#pragma unroll
        for (int q = 0; q < 2; ++q) { acc4 e;
#pragma unroll
            for (int r = 0; r < 4; ++r) { e.r[r] = vexp2(sc[2 * s2 + q].r[r] - mx); sum = sum + e.r[r]; }
            hh[q] = cvt4(e); }
        PF[s2] = join(hh[0], hh[1]); }
    sum = sum + shfl(sum, lane ^ vi(16)); sum = sum + shfl(sum, lane ^ vi(32));
    const vf inv = vf(1.f) / sum;
    vf invr[4];
#pragma unroll
    for (int r = 0; r < 4; ++r) invr[r] = shfl(inv, (fq << 2) + vi(r));
#pragma unroll 2
    for (int td = 0; td < XNTD; ++td) { acc4 o = acc_zero(); const vi rowb = ((vi(b * D + h * XHD + 16 * td) + fr) * vi(MEMT) + (fq << 2)) * vi(2);
#pragma unroll
        for (int s2 = 0; s2 < XNS; ++s2) o = mfma(PF[s2], join(g_ld_frag4(VT, rowb + vi(64 * s2)), g_ld_frag4(VT, rowb + vi(64 * s2 + 32))), o);
#pragma unroll
        for (int r = 0; r < 4; ++r) g_st_bf16(OX, (vi(n0 + r) + (fq << 2)) * vi(D) + vi(h * XHD + 16 * td) + fr, o.r[r] * invr[r]); }
}
enum { L_INPROJ = 0, L_PREP, L_M1  , L_M2  , L_M3  , L_COMBINE, L_OUTPROJ, L_LN1, L_XQ, L_XATT, L_XO, L_LN2,
       L_F1  , L_F2  , L_F3  , L_F4  , L_F5  , L_LN3, STEPS_PER_LAYER };
constexpr int N_STEPS = 2 + 2 * STEPS_PER_LAYER;
struct Exec {
    Ctx c; int G, blk, gw, nw, lane, tid, wave;
#ifndef CPU_TEST
    LAS unsigned char* lds; unsigned char* lds_generic;
#else
    unsigned char* lds;
#endif
};
#ifdef CPU_TEST
#define BLOCK_SYNC() do {} while (0)
#define RUN_GEMM(g, S, E) gemm_cpu(g, S, E, X.G)
constexpr int WVW = 1;
#define WAVE_ITEMS(n, call) do { const vi lane = lane_iota(); Lds WL = X.lds; for (int item = 0; item < (n); ++item) { call; } } while (0)
#define WAVE_ITEMS4(n, call) WAVE_ITEMS(n, call)
#else
#define BLOCK_SYNC() __syncthreads()
#define RUN_GEMM(g, S, E) gemm_phase(X.lds, X.tid, g, S, E)
constexpr int WVW = 64;
#define WAVE_ITEMS(n, call) do { Lds WL = X.lds + X.wave * 16384; for (int item = X.gw; item < (n); item += X.nw) { vi lane = X.lane; asm volatile("" : "+v"(lane)); call; } } while (0)
#define WAVE_ITEMS4(n, call) do { if (X.wave < 4) { Lds WL = X.lds + X.wave * 32768; for (int item = X.gw; item < (n); item += X.nw / 2) { vi lane = X.lane; asm volatile("" : "+v"(lane)); call; } } } while (0)
#endif
constexpr HD bool step_is_empty(int step) { if (step < 2) return false; const int l = (step - 2) / STEPS_PER_LAYER, s = (step - 2) % STEPS_PER_LAYER; return (l % 2 == 0) && (s >= L_F3 && s <= L_F5); }
#ifdef STEP_SET
#define EN(k) (((STEP_SET) >> (k)) & 1)
#else
#define EN(k) 1
#endif
HD int rot_id(int gtid, int gsz, int off) { long v = (long)gsz - 1 - gtid - (off % gsz); if (v < 0) v += gsz; return (int)v; }
DEV void run_step(const PRef p, int step, const Exec& X) {
    const Ctx& c = X.c;
    if (step == 0) { if (EN(30)) ph_prologue(p, c); return; }
    if (step == 1) { if (!EN(31)) return; Gemm g{WSP(const bf16_t, O_MEMB), WSP(const bf16_t, O_XKV_T), D, D, D}; SchedKV S; S.init(X.G, X.blk); EpiKV E{WSP(bf16_t, O_KMEM), WSP(bf16_t, O_VT)}; RUN_GEMM(g, S, E); return; }
    const int l = (step - 2) / STEPS_PER_LAYER, s = (step - 2) % STEPS_PER_LAYER; const bool moe = (l % 2) == 1;
    if (!EN(s)) return;
    switch (s) {
    case L_INPROJ: { Gemm g{WSP(const bf16_t, O_XB), WSP(const bf16_t, O_WIN_T) + (size_t)l * DINP * D, D, D, D}; SchedDense S; S.init(NTOK, DINP, D, D, X.G, X.blk);
        EpiStore E{WSP(bf16_t, O_PROJ), DINP, 1.0f}; RUN_GEMM(g, S, E); } break;
    case L_PREP: ph_prep(p, l, c); break;
    case L_M1: {
#ifdef CPU_TEST
        ph_attn_naive(p, c);
#else
        { const attn_body::AttnTensors AT{(const attn_body::bf16*)WSP(const bf16_t, O_QB), (const attn_body::bf16*)WSP(const bf16_t, O_KB), (const attn_body::bf16*)(WSP(const bf16_t, O_PROJ) + C_BV), (attn_body::bf16*)(WSP(bf16_t, O_MIXED) + 384)};
          attn_body::attn_phase<8>((char*)X.lds_generic, AT, X.G, X.blk); }
#endif
#if defined(NAIVE_SCANS) || defined(NAIVE_G) || defined(BISECT_G)
        { Ctx c2{rot_id(c.gtid, c.gsz, 0), c.gsz}; ph_gdn_naive(p, c2); }
#endif
#if !(defined(NAIVE_SCANS) || defined(NAIVE_G) || defined(BISECT_NO_M1))
        WAVE_ITEMS4(GSC * GNCH, gdn_m1(p, WL, lane, item));
        BLOCK_SYNC();
#endif
#if defined(NAIVE_SCANS) || defined(NAIVE_H)
        { Ctx c3{rot_id(c.gtid, c.gsz, 4096), c.gsz}; ph_hgrn_naive(p, c3); }
#else
        WAVE_ITEMS(HSC * HNCH, hgrn_m1(p, WL, lane, item));
#endif
        } break;
    case L_M2:
#if !defined(NAIVE_SCANS) && !defined(NAIVE_G)
        WAVE_ITEMS(GSC * 4, gdn_m2(p, lane, item));
#endif
#if !defined(NAIVE_SCANS) && !defined(NAIVE_H)
        WAVE_ITEMS(HSC * 16, hgrn_m2(p, lane, item));
#endif
        break;
    case L_M3:
#if !defined(NAIVE_SCANS) && !defined(NAIVE_G) && !defined(BISECT_G)
        WAVE_ITEMS(GSC * GNCH, gdn_m3(p, lane, item));
#endif
#if !defined(NAIVE_SCANS) && !defined(NAIVE_H)
        WAVE_ITEMS(HSC * HNCH, hgrn_m3(p, WL, lane, item));
#endif
        break;
    case L_COMBINE: ph_combine(p, l, c); break;
    case L_OUTPROJ: { Gemm g{WSP(const bf16_t, O_MIXED), WSP(const bf16_t, O_WOUT_T) + (size_t)l * D * MIXW, MIXW, MIXW, MIXW}; SchedDense S; S.init(NTOK, D, MIXW, MIXW, X.G, X.blk);
        EpiResid E{l == 0 ? p.k->in[I_X] : p.k->out, p.k->out}; RUN_GEMM(g, S, E); } break;
    case L_LN1: ph_ln<WVW>(p, p.k->in[I_LN1G] + l * D, p.k->in[I_LN1B] + l * D, 0, 0, nullptr, X.gw, X.nw, X.lane); break;
    case L_XQ: { Gemm g{WSP(const bf16_t, O_XB), WSP(const bf16_t, O_XQ_T) + (size_t)l * D * D, D, D, D}; SchedDense S; S.init(NTOK, D, D, D, X.G, X.blk);
        EpiStore E{WSP(bf16_t, O_QX), D, LOG2E / sqrtf((float)XHD)}; RUN_GEMM(g, S, E); } break;
    case L_XATT:
#ifdef NAIVE_XATT
        ph_xattn_naive(p, l, c);
#else
        WAVE_ITEMS(NTOK / 16 * XH, xattn_item(p, l, lane, item));
#endif
        break;
    case L_XO: { Gemm g{WSP(const bf16_t, O_MIXED), WSP(const bf16_t, O_XO_T) + (size_t)l * D * D, D, D, D}; SchedDense S; S.init(NTOK, D, D, D, X.G, X.blk);
        EpiResid E{p.k->out, p.k->out}; RUN_GEMM(g, S, E); } break;
    case L_LN2: ph_ln<WVW>(p, p.k->in[I_LN2G] + l * D, p.k->in[I_LN2B] + l * D, 0, moe ? 1 : 0, p.k->in[I_ROUTER] + (size_t)(l / 2) * D * NEXP, X.gw, X.nw, X.lane); break;
    case L_F1: if (!moe) { Gemm g{WSP(const bf16_t, O_XB), WSP(const bf16_t, O_FGU_T), D, D, D}; SchedDense S; S.init(NTOK, 2 * FF, D, D, X.G, X.blk); EpiSwiglu E{WSP(bf16_t, O_HID), FF}; RUN_GEMM(g, S, E); }
             else { ph_moe_weights(p, c); ph_moe_gather(p, c); } break;
    case L_F2: case L_F4:
        if (!moe) { if (s == L_F2) { Gemm g{WSP(const bf16_t, O_HID), WSP(const bf16_t, O_FD_T), FF, FF, FF}; SchedDense S; S.init(NTOK, D, FF, FF, X.G, X.blk); EpiResid E{p.k->out, p.k->out}; RUN_GEMM(g, S, E); } }
        else { Gemm g{WSP(const bf16_t, O_XG), WSP(const bf16_t, O_MGU_T), D, D, D}; SchedMoe S; S.init(WSP(const unsigned, O_CTL), s == L_F2 ? 0 : 1, 0, X.G, X.blk);
               EpiSwiglu E{WSP(bf16_t, O_HIDM), FFE}; RUN_GEMM(g, S, E); } break;
    case L_F3: case L_F5: if (moe) { Gemm g{WSP(const bf16_t, O_HIDM), WSP(const bf16_t, O_MD_T), FFE, FFE, FFE}; SchedMoe S; S.init(WSP(const unsigned, O_CTL), s == L_F3 ? 0 : 1, 1, X.G, X.blk);
                 EpiStore E{WSP(bf16_t, O_XG), D, 1.0f}; RUN_GEMM(g, S, E); } break;
    case L_LN3: ph_ln<WVW>(p, p.k->in[I_LN3G] + l * D, p.k->in[I_LN3B] + l * D, moe ? 1 : 0, 0, nullptr, X.gw, X.nw, X.lane); break;
    default: break;
    }
}

#ifndef CPU_TEST
namespace cg = cooperative_groups;
constexpr int LDS_BYTES = 147456;
__device__ __forceinline__ void run_step_fresh(int step) {
    KargPtr kp = (KargPtr)__builtin_amdgcn_kernarg_segment_ptr(); asm volatile("" : "+s"(kp));
    const PRef p{kp};
    extern __shared__ __attribute__((aligned(16))) unsigned char lds_raw[];
    int tid = threadIdx.x, blk = blockIdx.x, G = gridDim.x; asm volatile("" : "+v"(tid)); asm volatile("" : "+s"(blk)); asm volatile("" : "+s"(G));
    Exec X; const int wave = __builtin_amdgcn_readfirstlane(tid >> 6);
    X.G = G; X.blk = blk; X.tid = tid; X.wave = wave; X.lane = tid & 63; X.gw = wave * X.G + X.blk; X.nw = X.G * 8; X.c.gtid = X.gw * 64 + X.lane; X.c.gsz = X.nw * 64;
    X.lds = (LAS unsigned char*)lds_raw; X.lds_generic = lds_raw;
    run_step(p, step, X);
}
template <int STEP> __device__ __forceinline__ void prog(int lo, int hi, cg::grid_group& grid) {
    if constexpr (STEP < N_STEPS) {
        if constexpr (!step_is_empty(STEP)) { if (STEP >= lo && STEP < hi) { run_step_fresh(STEP); if (STEP + 1 < hi) grid.sync(); } }
        prog<STEP + 1>(lo, hi, grid);
    }
}
__global__ void __launch_bounds__(512, 2) mega(Params p) {
    cg::grid_group grid = cg::this_grid();
#ifdef ONLY_STEP
    run_step_fresh(ONLY_STEP); if (p.hi > 100) grid.sync();
#else
    prog<0>(p.lo, p.hi, grid);
#endif
}

extern "C" void kernel_launch(void* const* d_in, const int* in_sizes, int n_in, void* d_out, int out_size, void* d_ws, size_t ws_size, hipStream_t stream) {
    static int grid = 0;
    if (grid == 0) {
        if (n_in != N_IN || out_size != NTOK * D || ws_size < WS_TOTAL) { fprintf(stderr, "kernel_launch: unexpected problem (n_in %d, out %d, ws %zu < %zu)\n", n_in, out_size, ws_size, (size_t)WS_TOTAL); grid = -1; return; }
        int dev = 0, cus = 0, per_cu = 0;
        hipGetDevice(&dev); hipDeviceGetAttribute(&cus, hipDeviceAttributeMultiprocessorCount, dev);
        hipFuncSetAttribute((const void*)mega, hipFuncAttributeMaxDynamicSharedMemorySize, LDS_BYTES);
        hipOccupancyMaxActiveBlocksPerMultiprocessor(&per_cu, (const void*)mega, 512, LDS_BYTES);
        if (per_cu < 1) { fprintf(stderr, "kernel_launch: occupancy query says %d blocks per CU\n", per_cu); grid = -1; return; }
        grid = cus;
    }
    if (grid < 0) return;
    Params p{};
    for (int i = 0; i < N_IN; ++i) p.in[i] = (const float*)d_in[i];
    p.out = (float*)d_out; p.ws = (unsigned char*)d_ws;
#if defined(MULTI_LAUNCH)
    for (int s = 0; s < N_STEPS; ++s) { if (step_is_empty(s)) continue; p.lo = s; p.hi = s + 1; hipLaunchKernelGGL(mega, dim3(grid), dim3(512), LDS_BYTES, stream, p); }
#else
    p.lo = 0; p.hi = N_STEPS;
    void* args[] = {&p};
    hipError_t e = hipLaunchCooperativeKernel((const void*)mega, dim3(grid), dim3(512), args, LDS_BYTES, stream);
    if (e != hipSuccess) fprintf(stderr, "cooperative launch failed: %s (grid %d)\n", hipGetErrorString(e), grid);
#endif
}
#endif
```
